# Optimizing an MI355X kernel written in HIP

```python
import jax, jax.numpy as jnp
from jax import lax
import numpy as np

D_MODEL = 2048
BATCH = 4
SEQ = 2048
DEPTH = 1
DEC_BATCH = 32
DEC_SEQ = 1
PAST_LEN = 16384
PAGE_SIZE = 128

N_META = 16
GLA_HEADS = 4
GLA_DK = 128
GLA_DV = 256
GLA_RANK = 16
GLA_TAU = 16.0
GLA_CHUNK = 64
SWA_HEADS = 16
SWA_KV_HEADS = 4
SWA_GROUP = SWA_HEADS // SWA_KV_HEADS
SWA_HD = 64
WINDOW = 128
D_FF = 5632
EPS = 1e-6

GLA_QK = GLA_HEADS * GLA_DK
GLA_V = GLA_HEADS * GLA_DV
SWA_Q = SWA_HEADS * SWA_HD
SWA_KV = SWA_KV_HEADS * SWA_HD
SPLITS = (GLA_QK, GLA_QK, GLA_V, GLA_V, GLA_RANK, SWA_Q, SWA_KV, SWA_KV, D_MODEL, D_MODEL)
IN_PROJ = 2 * GLA_QK + 2 * GLA_V + GLA_RANK + SWA_Q + 2 * SWA_KV + 2 * D_MODEL

kernel_name = "hybrid_gla_swa_macaron_meta_step"

F32 = jnp.float32


def rmsnorm(x, g):
    xf = x.astype(F32)
    y = xf * lax.rsqrt(jnp.mean(xf * xf, axis=-1, keepdims=True) + EPS)
    return (y * g.astype(F32)).astype(x.dtype)


def half_ffn(h, g, w_in, w_out):
    u = rmsnorm(h, g) @ w_in
    a, b = jnp.split(u, 2, axis=-1)
    return h + 0.5 * ((jax.nn.silu(a) * b) @ w_out)


def in_projection(h, g, w_in):
    u = rmsnorm(h, g) @ w_in
    parts = []
    off = 0
    for n in SPLITS:
        parts.append(u[..., off:off + n])
        off += n
    return parts


def alibi_slopes():
    h = jnp.arange(1, SWA_HEADS + 1, dtype=F32)
    return jnp.exp2(-8.0 * h / SWA_HEADS).reshape(SWA_KV_HEADS, SWA_GROUP)


def sink_softmax(s, sinks):
    sk = sinks.astype(F32).reshape(SWA_KV_HEADS, SWA_GROUP, 1)
    m = jnp.maximum(jnp.max(s, axis=-1), sk)
    p = jnp.exp(s - m[..., None])
    return p / (jnp.sum(p, axis=-1, keepdims=True) + jnp.exp(sk - m)[..., None])


def gla_inputs(gq, gk, gv, gad, a_up, a_bias):
    lead = gq.shape[:-1]
    q = gq.astype(F32).reshape(*lead, GLA_HEADS, GLA_DK) * (GLA_DK ** -0.5)
    k = gk.astype(F32).reshape(*lead, GLA_HEADS, GLA_DK)
    v = gv.astype(F32).reshape(*lead, GLA_HEADS, GLA_DV)
    logg = jax.nn.log_sigmoid((gad @ a_up + a_bias).astype(F32)) / GLA_TAU
    return q, k, v, logg.reshape(*lead, GLA_HEADS, GLA_DK)


def gla_scan(q, k, v, logg, s0, chunk):
    B, L, H, _ = q.shape
    n = L // chunk

    def to_chunks(t):
        return jnp.moveaxis(t.reshape(B, n, chunk, H, t.shape[-1]), 1, 0)

    causal = jnp.tril(jnp.ones((chunk, chunk), dtype=bool))[None, :, :, None, None]

    def step(S, xs):
        qc, kc, vc, gc = xs
        b = jnp.cumsum(gc, axis=1)
        diff = b[:, :, None] - b[:, None, :]
        decay = jnp.exp(jnp.where(causal, diff, -jnp.inf))
        att = jnp.einsum('bthd,bshd,btshd->bhts', qc, kc, decay)
        o = (jnp.einsum('bhts,bshv->bthv', att, vc)
             + jnp.einsum('bthd,bhdv->bthv', qc * jnp.exp(b), S))
        b_last = b[:, -1]
        S = (S * jnp.exp(b_last)[..., None]
             + jnp.einsum('bshd,bshv->bhdv', kc * jnp.exp(b_last[:, None] - b), vc))
        return S, o

    S, o = lax.scan(step, s0, (to_chunks(q), to_chunks(k), to_chunks(v), to_chunks(logg)))
    o = jnp.moveaxis(o, 0, 1).reshape(B, L, H, GLA_DV)
    return o, S


def gla_branch_out(o, r, onorm, w_o):
    of = o * lax.rsqrt(jnp.mean(o * o, axis=-1, keepdims=True) + EPS)
    of = of * onorm.astype(F32).reshape(GLA_HEADS, GLA_DV)
    of = of.reshape(*o.shape[:-2], GLA_V) * jax.nn.silu(r.astype(F32))
    return of.astype(r.dtype) @ w_o


def swa_prompt(q, k, v, sinks):
    B, LT, _ = q.shape
    S = LT - N_META
    nb = S // WINDOW
    q = q.astype(F32).reshape(B, LT, SWA_KV_HEADS, SWA_GROUP, SWA_HD) * (SWA_HD ** -0.5)
    k = k.astype(F32).reshape(B, LT, SWA_KV_HEADS, SWA_HD)
    v = v.astype(F32).reshape(B, LT, SWA_KV_HEADS, SWA_HD)
    qm, qr = q[:, :N_META], q[:, N_META:]
    km, kr = k[:, :N_META], k[:, N_META:]
    vm, vr = v[:, :N_META], v[:, N_META:]
    causal_m = jnp.tril(jnp.ones((N_META, N_META), dtype=bool))
    s_mm = jnp.where(causal_m, jnp.einsum('bqkgd,bskd->bkgqs', qm, km), -jnp.inf)
    o_m = jnp.einsum('bkgqs,bskd->bqkgd', sink_softmax(s_mm, sinks), vm)
    qb = qr.reshape(B, nb, WINDOW, SWA_KV_HEADS, SWA_GROUP, SWA_HD)
    kb = kr.reshape(B, nb, WINDOW, SWA_KV_HEADS, SWA_HD)
    vb = vr.reshape(B, nb, WINDOW, SWA_KV_HEADS, SWA_HD)
    pad = ((0, 0), (1, 0), (0, 0), (0, 0), (0, 0))
    kw = jnp.concatenate([jnp.pad(kb, pad)[:, :-1], kb], axis=2)
    vw = jnp.concatenate([jnp.pad(vb, pad)[:, :-1], vb], axis=2)
    i = jnp.arange(WINDOW)[:, None]
    j = jnp.arange(2 * WINDOW)[None, :]
    dist = i + WINDOW - j
    blk = jnp.arange(nb)[:, None, None]
    valid = (dist >= 0) & (dist < WINDOW) & (blk * WINDOW + j[None] - WINDOW >= 0)
    slopes = alibi_slopes()[:, :, None, None]
    s_win = jnp.einsum('bnqkgd,bnskd->bnkgqs', qb, kw) - slopes * dist.astype(F32)
    s_win = jnp.where(valid[None, :, None, None], s_win, -jnp.inf)
    s_meta = jnp.einsum('bnqkgd,bskd->bnkgqs', qb, km)
    p = sink_softmax(jnp.concatenate([s_meta, s_win], axis=-1), sinks)
    o_r = (jnp.einsum('bnkgqs,bskd->bnqkgd', p[..., :N_META], vm)
           + jnp.einsum('bnkgqs,bnskd->bnqkgd', p[..., N_META:], vw))
    return jnp.concatenate([o_m.reshape(B, N_META, SWA_Q), o_r.reshape(B, S, SWA_Q)], axis=1)


def swa_sample(q, k, v, meta_k, meta_v, win_k, win_v, sinks):
    DB, T, _ = q.shape
    WB = win_k.shape[1]
    q = q.astype(F32).reshape(DB, T, SWA_KV_HEADS, SWA_GROUP, SWA_HD) * (SWA_HD ** -0.5)
    kw = jnp.concatenate([win_k.astype(F32), k.astype(F32).reshape(DB, T, SWA_KV_HEADS, SWA_HD)], axis=1)
    vw = jnp.concatenate([win_v.astype(F32), v.astype(F32).reshape(DB, T, SWA_KV_HEADS, SWA_HD)], axis=1)
    i = jnp.arange(T)[:, None]
    c = jnp.arange(WB + T)[None, :]
    dist = i + WB - c
    valid = (dist >= 0) & (dist < WINDOW) & (PAST_LEN - WB + c >= N_META)
    slopes = alibi_slopes()[:, :, None, None]
    s_win = jnp.einsum('bqkgd,bskd->bkgqs', q, kw) - slopes * dist.astype(F32)
    s_win = jnp.where(valid, s_win, -jnp.inf)
    mk = meta_k.astype(F32)
    mv = meta_v.astype(F32)
    s_meta = jnp.einsum('bqkgd,bskd->bkgqs', q, mk)
    p = sink_softmax(jnp.concatenate([s_meta, s_win], axis=-1), sinks)
    o = (jnp.einsum('bkgqs,bskd->bqkgd', p[..., :N_META], mv)
         + jnp.einsum('bkgqs,bskd->bqkgd', p[..., N_META:], vw))
    new_k = kw[:, -WB:].astype(win_k.dtype)
    new_v = vw[:, -WB:].astype(win_v.dtype)
    return o.reshape(DB, T, SWA_Q), new_k, new_v


def merge(gla_b, swa_b, ga, gb, gate_bias, w_out):
    m = (jax.nn.sigmoid(ga + gate_bias[:D_MODEL]) * gla_b
         + jax.nn.sigmoid(gb + gate_bias[D_MODEL:]) * swa_b)
    return m @ w_out


def setup_inputs(seed: int = 0) -> dict:
    key = jax.random.key(seed)
    ks = jax.random.split(key, 32)
    WB = min(WINDOW, PAST_LEN)

    def nrm(k, shape, scale):
        return jax.random.normal(k, shape, F32) * scale

    def gain(k, shape):
        return 1.0 + 0.02 * jax.random.normal(k, shape, F32)

    return {
        "x_prompt": nrm(ks[0], (BATCH, SEQ, D_MODEL), 1.0),
        "x_sample": nrm(ks[1], (DEC_BATCH, DEC_SEQ, D_MODEL), 1.0),
        "cache_meta_k": nrm(ks[2], (DEPTH, DEC_BATCH, N_META, SWA_KV_HEADS, SWA_HD), 1.0),
        "cache_meta_v": nrm(ks[3], (DEPTH, DEC_BATCH, N_META, SWA_KV_HEADS, SWA_HD), 1.0),
        "cache_win_k": nrm(ks[4], (DEPTH, DEC_BATCH, WB, SWA_KV_HEADS, SWA_HD), 1.0),
        "cache_win_v": nrm(ks[5], (DEPTH, DEC_BATCH, WB, SWA_KV_HEADS, SWA_HD), 1.0),
        "state_gla": nrm(ks[6], (DEPTH, DEC_BATCH, GLA_HEADS, GLA_DK, GLA_DV), 1.0),
        "meta_tokens": nrm(ks[7], (N_META, D_MODEL), 1.0),
        "ffn1_norm": gain(ks[8], (DEPTH, D_MODEL)),
        "ffn1_w_in": nrm(ks[9], (DEPTH, D_MODEL, 2 * D_FF), D_MODEL ** -0.5),
        "ffn1_w_out": nrm(ks[10], (DEPTH, D_FF, D_MODEL), D_FF ** -0.5),
        "mix_norm": gain(ks[11], (DEPTH, D_MODEL)),
        "w_in": nrm(ks[12], (DEPTH, D_MODEL, IN_PROJ), D_MODEL ** -0.5),
        "gla_a_up": nrm(ks[13], (DEPTH, GLA_RANK, GLA_QK), GLA_RANK ** -0.5),
        "gla_a_bias": nrm(ks[14], (DEPTH, GLA_QK), 0.1),
        "gla_out_norm": gain(ks[15], (DEPTH, GLA_V)),
        "w_gla_o": nrm(ks[16], (DEPTH, GLA_V, D_MODEL), GLA_V ** -0.5),
        "swa_sinks": nrm(ks[17], (DEPTH, SWA_HEADS), 0.5),
        "w_swa_o": nrm(ks[18], (DEPTH, SWA_Q, D_MODEL), SWA_Q ** -0.5),
        "gate_bias": nrm(ks[19], (DEPTH, 2 * D_MODEL), 0.1),
        "w_out": nrm(ks[20], (DEPTH, D_MODEL, D_MODEL), D_MODEL ** -0.5),
        "ffn2_norm": gain(ks[21], (DEPTH, D_MODEL)),
        "ffn2_w_in": nrm(ks[22], (DEPTH, D_MODEL, 2 * D_FF), D_MODEL ** -0.5),
        "ffn2_w_out": nrm(ks[23], (DEPTH, D_FF, D_MODEL), D_FF ** -0.5),
        "final_norm": gain(ks[24], (D_MODEL,)),
    }


def reference(x_prompt, x_sample, cache_meta_k, cache_meta_v, cache_win_k, cache_win_v, state_gla,
              meta_tokens, ffn1_norm, ffn1_w_in, ffn1_w_out, mix_norm, w_in, gla_a_up, gla_a_bias,
              gla_out_norm, w_gla_o, swa_sinks, w_swa_o, gate_bias, w_out, ffn2_norm, ffn2_w_in,
              ffn2_w_out, final_norm):
    B = x_prompt.shape[0]
    DB = x_sample.shape[0]
    meta = jnp.broadcast_to(meta_tokens.astype(x_prompt.dtype)[None], (B, N_META, D_MODEL))
    hp = jnp.concatenate([meta, x_prompt], axis=1)
    hs = x_sample
    p_meta_k, p_meta_v, p_win_k, p_win_v, p_gla = [], [], [], [], []
    s_win_k, s_win_v, s_gla = [], [], []
    for l in range(DEPTH):
        hp = half_ffn(hp, ffn1_norm[l], ffn1_w_in[l], ffn1_w_out[l])
        hs = half_ffn(hs, ffn1_norm[l], ffn1_w_in[l], ffn1_w_out[l])

        gq, gk, gv, gr, gad, sq, sk, sv, ga, gb = in_projection(hp, mix_norm[l], w_in[l])
        q, k, v, logg = gla_inputs(gq, gk, gv, gad, gla_a_up[l], gla_a_bias[l])
        s0 = jnp.zeros((B, GLA_HEADS, GLA_DK, GLA_DV), F32)
        o_meta, st_meta = gla_scan(q[:, :N_META], k[:, :N_META], v[:, :N_META], logg[:, :N_META], s0, N_META)
        o_real, st_fin = gla_scan(q[:, N_META:], k[:, N_META:], v[:, N_META:], logg[:, N_META:], st_meta, GLA_CHUNK)
        gla_b = gla_branch_out(jnp.concatenate([o_meta, o_real], axis=1), gr, gla_out_norm[l], w_gla_o[l])
        swa_b = swa_prompt(sq, sk, sv, swa_sinks[l]).astype(hp.dtype) @ w_swa_o[l]
        hp = hp + merge(gla_b, swa_b, ga, gb, gate_bias[l], w_out[l])
        p_meta_k.append(sk[:, :N_META].reshape(B, N_META, SWA_KV_HEADS, SWA_HD))
        p_meta_v.append(sv[:, :N_META].reshape(B, N_META, SWA_KV_HEADS, SWA_HD))
        p_win_k.append(sk[:, -WINDOW:].reshape(B, WINDOW, SWA_KV_HEADS, SWA_HD))
        p_win_v.append(sv[:, -WINDOW:].reshape(B, WINDOW, SWA_KV_HEADS, SWA_HD))
        p_gla.append(st_fin.astype(hp.dtype))

        gq, gk, gv, gr, gad, sq, sk, sv, ga, gb = in_projection(hs, mix_norm[l], w_in[l])
        q, k, v, logg = gla_inputs(gq, gk, gv, gad, gla_a_up[l], gla_a_bias[l])
        o_s, st_s = gla_scan(q, k, v, logg, state_gla[l].astype(F32), q.shape[1])
        gla_b = gla_branch_out(o_s, gr, gla_out_norm[l], w_gla_o[l])
        o_w, nwk, nwv = swa_sample(sq, sk, sv, cache_meta_k[l], cache_meta_v[l],
                                   cache_win_k[l], cache_win_v[l], swa_sinks[l])
        swa_b = o_w.astype(hs.dtype) @ w_swa_o[l]
        hs = hs + merge(gla_b, swa_b, ga, gb, gate_bias[l], w_out[l])
        s_win_k.append(nwk)
        s_win_v.append(nwv)
        s_gla.append(st_s.astype(state_gla.dtype))

        hp = half_ffn(hp, ffn2_norm[l], ffn2_w_in[l], ffn2_w_out[l])
        hs = half_ffn(hs, ffn2_norm[l], ffn2_w_in[l], ffn2_w_out[l])

    y_prompt = rmsnorm(hp[:, N_META:], final_norm)
    y_sample = rmsnorm(hs, final_norm)
    return (y_prompt, y_sample,
            jnp.stack(p_meta_k), jnp.stack(p_meta_v), jnp.stack(p_win_k), jnp.stack(p_win_v), jnp.stack(p_gla),
            jnp.stack(s_win_k), jnp.stack(s_win_v), jnp.stack(s_gla))
```

```cpp
#include <hip/hip_runtime.h>
#include <hip/hip_cooperative_groups.h>
#include <cstdio>
#include <cstdint>
namespace cg = cooperative_groups;
#ifndef MK_LAUNCHES
#define MK_LAUNCHES 11
#endif
namespace pg8 {
#define PG8_LAS __attribute__((address_space(3)))
typedef unsigned short bf16_t;
typedef short bf16x8 __attribute__((ext_vector_type(8)));
typedef float f32x4 __attribute__((ext_vector_type(4)));
typedef unsigned u32x4 __attribute__((ext_vector_type(4)));
constexpr int BM = 256, BK = 64, HALF = 128, HTB = HALF * BK * 2  , STAGE_BYTES = 8 * HTB, NXCD = 8, WGM = 8;

__host__ __device__ __forceinline__ int lds_byte(int r, int c) { const int st = (r >> 4) * 2 + (c >> 5), rr = r & 15, cc = c & 31, ob = rr * 64 + cc * 2; return st * 1024 + (ob ^ (((ob >> 9) & 1) << 5)); }
__host__ __device__ __forceinline__ void stage_rc(int b, int& R, int& C) { const int st = b / 1024, sb = b % 1024, swz = sb ^ (((sb >> 9) & 1) << 5); R = (st >> 1) * 16 + swz / 64; C = (st & 1) * 32 + (swz % 64) / 2; }
__host__ __device__ __forceinline__ int perm32(int rho) { const int n = rho >> 4, i = rho & 15; return 8 * (i >> 2) + 4 * n + (i & 3); }
struct Unit { int pm, pn; };
struct Gemm { const bf16_t* A; const bf16_t* Bt; int M, N, K; };

struct StaticOrder {
    int nM, nN, nwg, G, c;
    __host__ __device__ void init(int M, int N, int G_, int c_) { nM = M / BM; nN = N / BM; nwg = nM * nN; G = G_; c = c_; }
    __host__ __device__ bool next(int i, Unit& u) const {
        const long L = (long)i * G + c; if (L >= nwg) return false;
        int wgid = (int)L; { const int q = nwg / NXCD, r = nwg % NXCD, xcd = wgid % NXCD, off = wgid / NXCD; wgid = (xcd < r ? xcd * (q + 1) : r * (q + 1) + (xcd - r) * q) + off; }
        const int nig = WGM * nN, gid = wgid / nig, fm = gid * WGM, gsz = (nM - fm) < WGM ? (nM - fm) : WGM;
        u.pm = fm + ((wgid % nig) % gsz); u.pn = (wgid % nig) / gsz; return true;
    }
    __device__ __forceinline__ void a_ready(const Unit&) const {}
    __device__ __forceinline__ void done(const Unit&) const {}
};
typedef __bf16 bf16v2_t __attribute__((ext_vector_type(2)));
typedef float f32v2_t __attribute__((ext_vector_type(2)));
__device__ __forceinline__ unsigned cvt_pk_bf16_c(float lo, float hi) { f32v2_t v = {lo, hi}; bf16v2_t b = __builtin_convertvector(v, bf16v2_t); unsigned r; __builtin_memcpy(&r, &b, 4); return r; }
__device__ __forceinline__ unsigned cvt_pk_bf16(float lo, float hi) { unsigned r; asm volatile("v_cvt_pk_bf16_f32 %0, %1, %2" : "=v"(r) : "v"(lo), "v"(hi)); return r; }
template <class Epi, class Sched, bool STAMP = false>
__device__ __forceinline__ void gemm_phase(PG8_LAS unsigned char* lds, const Gemm g, const Sched& S, const Epi& E, unsigned long long* stamps) {
    const int tid = threadIdx.x, wid = __builtin_amdgcn_readfirstlane(tid >> 6), lane = tid & 63, wr = wid >> 2, wc = wid & 3, fr = lane & 15, fq = lane >> 4;
    const int K = g.K, nt = K / BK;
    int ts_lo = 0, ts_hi = 0, nts = 0; const unsigned long long rt_entry = STAMP ? (unsigned long long)wall_clock64() : 0ull;
#define PG8_STAMP() do { if (STAMP && wid == 0 && nts < 64) { const unsigned long long _c = (unsigned long long)clock64(); \
        ts_lo = (lane == nts) ? (int)(unsigned)_c : ts_lo; ts_hi = (lane == nts) ? (int)(unsigned)(_c >> 32) : ts_hi; ++nts; } } while (0)
    PG8_STAMP();
    unsigned voffA[2], voffB[2];
#pragma unroll
    for (int i = 0; i < 2; ++i) { int R, C; stage_rc(tid * 16 + i * 8192, R, C); const int Rb = Epi::PERM ? ((R & ~31) + perm32(R & 31)) : R;
        voffA[i] = (unsigned)(R * K + C) * 2u; voffB[i] = (unsigned)(Rb * K + C) * 2u; }
    const size_t kstep = (size_t)(BK * 2);
    const size_t hstep = (size_t)HALF * K * 2;
    const size_t tstep = 2 * hstep;
    const unsigned ldsw = (unsigned)wid * 1024u;
    const int aoff = lds_byte(wr * 64 + fr, fq * 8), boff = lds_byte(wc * 32 + fr, fq * 8);
#define PG8_SA(b, h) (((b) * 2 + (h)) * HTB)
#define PG8_SB(b, h) ((4 + (b) * 2 + (h)) * HTB)
#define PG8_STAGE(bufoff, gbase, voff) do { _Pragma("unroll") for (int _i = 0; _i < 2; ++_i) \
        __builtin_amdgcn_global_load_lds((const unsigned*)((const char*)(gbase) + (voff)[_i]), (PG8_LAS unsigned*)(lds + (bufoff) + ldsw + _i * 8192), 16, 0, 0); } while (0)
#define PG8_LDA(dst, b, h) do { _Pragma("unroll") for (int m = 0; m < 4; ++m) _Pragma("unroll") for (int k = 0; k < 2; ++k) dst[m][k] = *(const PG8_LAS bf16x8*)(lds + PG8_SA(b, h) + aoff + m * 2048 + k * 1024); } while (0)
#define PG8_LDB(dst, b, h) do { _Pragma("unroll") for (int n = 0; n < 2; ++n) _Pragma("unroll") for (int k = 0; k < 2; ++k) dst[n][k] = *(const PG8_LAS bf16x8*)(lds + PG8_SB(b, h) + boff + n * 2048 + k * 1024); } while (0)
#define PG8_MMA(ai, bj, At, Bt) do { __builtin_amdgcn_s_setprio(1); _Pragma("unroll") for (int m = 0; m < 4; ++m) _Pragma("unroll") for (int n = 0; n < 2; ++n) _Pragma("unroll") for (int k = 0; k < 2; ++k) \
        acc[ai][bj][m][n] = __builtin_amdgcn_mfma_f32_16x16x32_bf16(Bt[n][k], At[m][k], acc[ai][bj][m][n], 0, 0, 0); __builtin_amdgcn_s_setprio(0); } while (0)
#define PG8_WAIT_V(n) asm volatile("s_waitcnt vmcnt(" #n ")" ::: "memory")
#define PG8_WAIT_L(n) asm volatile("s_waitcnt lgkmcnt(" #n ")" ::: "memory")
#define PG8_BAR __builtin_amdgcn_s_barrier()
#define PG8_SCHED __builtin_amdgcn_sched_barrier(0)
    Unit cur, nxt; int ui = 0;
    if (!S.next(0, cur)) return;
    f32x4 acc[2][2][4][2];
#pragma unroll
    for (int a = 0; a < 2; ++a)
#pragma unroll
        for (int b = 0; b < 2; ++b)
#pragma unroll
            for (int m = 0; m < 4; ++m)
#pragma unroll
                for (int n = 0; n < 2; ++n) acc[a][b][m][n] = (f32x4){0.f, 0.f, 0.f, 0.f};
    bf16x8 At[4][2], B0[2][2], B1[2][2];
    const char* cA = (const char*)g.A + (size_t)cur.pm * tstep; const char* cB = (const char*)g.Bt + (size_t)cur.pn * tstep;
    S.a_ready(cur);
    PG8_STAGE(PG8_SB(0, 0), cB, voffB); PG8_STAGE(PG8_SA(0, 0), cA, voffA); PG8_STAGE(PG8_SB(0, 1), cB + hstep, voffB); PG8_STAGE(PG8_SA(0, 1), cA + hstep, voffA);
    if (wr == 1) PG8_BAR;
    PG8_WAIT_V(4); PG8_BAR;
    PG8_STAGE(PG8_SB(1, 0), cB + kstep, voffB); PG8_STAGE(PG8_SA(1, 0), cA + kstep, voffA); PG8_STAGE(PG8_SB(1, 1), cB + hstep + kstep, voffB);
    PG8_WAIT_V(6); PG8_BAR;
    PG8_STAMP();
    for (;;) {
        const bool has_next = S.next(ui + 1, nxt);
        const char* nA = has_next ? (const char*)g.A + (size_t)nxt.pm * tstep : cA; const char* nB = has_next ? (const char*)g.Bt + (size_t)nxt.pn * tstep : cB;
        for (int t = 0; t < nt; t += 2) {
            const bool last = (t == nt - 2);
            const char* a1 = cA + (size_t)(t + 1) * kstep;
            const char* a2 = last ? nA : cA + (size_t)(t + 2) * kstep; const char* b2 = last ? nB : cB + (size_t)(t + 2) * kstep;
            const char* a3 = a2 + kstep; const char* b3 = b2 + kstep;
            if (last && has_next) S.a_ready(nxt);
            PG8_LDB(B0, 0, 0); PG8_SCHED; PG8_LDA(At, 0, 0); PG8_STAGE(PG8_SA(1, 1), a1 + hstep, voffA);
            PG8_WAIT_L(8); PG8_BAR; PG8_WAIT_L(0); PG8_MMA(0, 0, At, B0); PG8_BAR; PG8_SCHED;
            PG8_LDB(B1, 0, 1); PG8_STAGE(PG8_SB(0, 0), b2, voffB);
            PG8_BAR; PG8_WAIT_L(0); PG8_MMA(0, 1, At, B1); PG8_BAR;
            PG8_LDA(At, 0, 1); PG8_STAGE(PG8_SA(0, 0), a2, voffA);
            PG8_BAR; PG8_WAIT_L(0); PG8_MMA(1, 0, At, B0); PG8_BAR; PG8_SCHED;
            PG8_STAGE(PG8_SB(0, 1), b2 + hstep, voffB);
            PG8_WAIT_V(6); PG8_BAR; PG8_MMA(1, 1, At, B1); PG8_BAR;
            PG8_LDB(B0, 1, 0); PG8_SCHED; PG8_LDA(At, 1, 0); PG8_STAGE(PG8_SA(0, 1), a2 + hstep, voffA);
            PG8_WAIT_L(8); PG8_BAR; PG8_WAIT_L(0); PG8_MMA(0, 0, At, B0); PG8_BAR; PG8_SCHED;
            PG8_LDB(B1, 1, 1); PG8_STAGE(PG8_SB(1, 0), b3, voffB);
            PG8_BAR; PG8_WAIT_L(0); PG8_MMA(0, 1, At, B1); PG8_BAR;
            PG8_LDA(At, 1, 1); PG8_STAGE(PG8_SA(1, 0), a3, voffA);
            PG8_BAR; PG8_WAIT_L(0); PG8_MMA(1, 0, At, B0); PG8_BAR; PG8_SCHED;
            PG8_STAGE(PG8_SB(1, 1), b3 + hstep, voffB);
            PG8_WAIT_V(6); PG8_BAR; PG8_MMA(1, 1, At, B1); PG8_BAR;
        }
        PG8_STAMP();
        if constexpr (!Epi::AFTER_DRAIN) { E(acc, cur, wr, wc, fr, fq); S.done(cur); }
        PG8_STAMP();
        if (!has_next) break;
#pragma unroll
        for (int a = 0; a < 2; ++a)
#pragma unroll
            for (int b = 0; b < 2; ++b)
#pragma unroll
                for (int m = 0; m < 4; ++m)
#pragma unroll
                    for (int n = 0; n < 2; ++n) acc[a][b][m][n] = (f32x4){0.f, 0.f, 0.f, 0.f};
        cur = nxt; cA = nA; cB = nB; ++ui;
    }
    PG8_WAIT_V(0);
    if (wr == 0) PG8_BAR;
    PG8_BAR;
    if constexpr (Epi::AFTER_DRAIN) { E.fused(acc, cur, wr, wc, fr, fq, lds, wid, lane); S.done(cur); }
    PG8_STAMP();
    if (STAMP && wid == 0) { stamps[lane] = lane < nts ? (((unsigned long long)(unsigned)ts_hi << 32) | (unsigned)ts_lo) : 0ull;
        if (lane == 62) stamps[62] = rt_entry; if (lane == 63) stamps[63] = (unsigned long long)wall_clock64(); }
#undef PG8_STAMP
#undef PG8_SA
#undef PG8_SB
#undef PG8_STAGE
#undef PG8_LDA
#undef PG8_LDB
#undef PG8_MMA
#undef PG8_WAIT_V
#undef PG8_WAIT_L
#undef PG8_BAR
#undef PG8_SCHED
}
}

using pg8::bf16_t; using pg8::bf16x8; using pg8::f32x4; using pg8::u32x4; using pg8::cvt_pk_bf16;
typedef unsigned u32x2 __attribute__((ext_vector_type(2)));
constexpr int DM = 2048, FF = 5632, NPR = 8192, R_META = 8192, R_SAMP = 8208, RT = 8448;
constexpr int UW = 8720;
constexpr int U_GQ = 0, U_GK = 512, U_GV = 1024, U_GR = 2048, U_SQ = 3072, U_SK = 4096, U_SV = 4352, U_GA = 4608, U_GB = 6656, U_GAD = 8704;
constexpr int NIN_PAD = 8960;
constexpr float EPSV = 1e-6f;
constexpr size_t O_YP = 0, O_YS = 16777216, O_PMK = 16842752, O_PMV = 16859136, O_PWK = 16875520, O_PWV = 17006592, O_PGLA = 17137664,
                 O_SWK = 17661952, O_SWV = 18710528, O_SGLA = 19759104;
constexpr size_t WS_BT1IN = 0;
constexpr size_t WS_BT1OUT = WS_BT1IN + (size_t)11264 * 2048 * 2;
constexpr size_t WS_BTIN = WS_BT1OUT + (size_t)2048 * 5632 * 2;
constexpr size_t WS_BTGO = WS_BTIN + (size_t)NIN_PAD * 2048 * 2;
constexpr size_t WS_BTSO = WS_BTGO + (size_t)2048 * 1024 * 2;
constexpr size_t WS_BTOUT = WS_BTSO + (size_t)2048 * 1024 * 2;
constexpr size_t WS_BT2IN = WS_BTOUT + (size_t)2048 * 2048 * 2;
constexpr size_t WS_BT2OUT = WS_BT2IN + (size_t)11264 * 2048 * 2;
constexpr size_t WS_A = WS_BT2OUT + (size_t)2048 * 5632 * 2;
constexpr size_t WS_UH = WS_A + (size_t)RT * 2048 * 2;
constexpr size_t WS_OG = WS_UH + (size_t)RT * UW * 2;
constexpr size_t WS_O = WS_OG + (size_t)RT * 1024 * 2;
constexpr size_t WS_PART = WS_O + (size_t)RT * 1024 * 2;
constexpr size_t WS_HX = WS_PART + (size_t)RT * 32 * 4;
constexpr size_t WS_END = WS_HX + (size_t)256 * 2048 * 4;
constexpr int LDS_BYTES = 131072;
constexpr int NPHASE = 11;

struct Params { const float* in[25]; float* out; unsigned char* ws; int ph_lo, ph_hi; };

__device__ __forceinline__ float bf2f(unsigned short b) { return __uint_as_float(((unsigned)b) << 16); }
__device__ __forceinline__ float bflo(unsigned w) { return __uint_as_float(w << 16); }
__device__ __forceinline__ float bfhi(unsigned w) { return __uint_as_float(w & 0xffff0000u); }
__device__ __forceinline__ unsigned short f2bf(float f) { return (unsigned short)(cvt_pk_bf16(f, 0.f) & 0xffffu); }
__device__ __forceinline__ float wave_sum(float v) {
#pragma unroll
    for (int o = 1; o < 64; o <<= 1) v += __shfl_xor(v, o);
    return v;
}
__device__ __forceinline__ float wave_max(float v) {
#pragma unroll
    for (int o = 1; o < 64; o <<= 1) v = fmaxf(v, __shfl_xor(v, o));
    return v;
}
__device__ __forceinline__ float sigmoidf_(float x) { return 1.f / (1.f + __expf(-x)); }
__device__ __forceinline__ float siluf_(float x) { return x / (1.f + __expf(-x)); }
__device__ __forceinline__ float logsigf_(float x) { return fminf(x, 0.f) - log1pf(__expf(-fabsf(x))); }
__device__ __forceinline__ f32x4 mfma16(bf16x8 a, bf16x8 b, f32x4 c) { return __builtin_amdgcn_mfma_f32_16x16x32_bf16(a, b, c, 0, 0, 0); }
__device__ __forceinline__ u32x2 pack4(f32x4 v) { u32x2 r; r.x = cvt_pk_bf16(v[0], v[1]); r.y = cvt_pk_bf16(v[2], v[3]); return r; }
__device__ __forceinline__ u32x2 pack4c(f32x4 v) { u32x2 r; r.x = pg8::cvt_pk_bf16_c(v[0], v[1]); r.y = pg8::cvt_pk_bf16_c(v[2], v[3]); return r; }
__device__ __forceinline__ float rstd_of(const float* part, int row) {
    const f32x4* p = (const f32x4*)(part + (size_t)row * 32);
    f32x4 s = p[0];
#pragma unroll
    for (int i = 1; i < 8; ++i) s += p[i];
    return rsqrtf(((s[0] + s[1]) + (s[2] + s[3])) * (1.f / 2048.f) + EPSV);
}

template <int MODE> struct Epi {
    static constexpr bool PERM = false, AFTER_DRAIN = false;
    bf16_t* outb; float* hmain; float* hx; const float* part_in; float* part_out; const float* gvec; const bf16_t* U; const float* gbias; float scale;
    __device__ __forceinline__ void operator()(const f32x4 (&acc)[2][2][4][2], const pg8::Unit& u, int wr, int wc, int fr, int fq) const {
        const int row0 = u.pm * 256 + wr * 64 + fr;
        if constexpr (MODE == 0) {
            const int j0 = u.pn * 128 + wc * 16 + 4 * fq;
#pragma unroll
            for (int ai = 0; ai < 2; ++ai)
#pragma unroll
                for (int m = 0; m < 4; ++m) {
                    const int row = row0 + ai * 128 + m * 16; const float rs = rstd_of(part_in, row);
#pragma unroll
                    for (int bj = 0; bj < 2; ++bj) {
                        f32x4 a = acc[ai][bj][m][0] * rs, b = acc[ai][bj][m][1] * rs, hv;
#pragma unroll
                        for (int j = 0; j < 4; ++j) hv[j] = siluf_(a[j]) * b[j];
                        *(u32x2*)(outb + (size_t)row * FF + j0 + bj * 64) = pack4(hv);
                    }
                }
        } else if constexpr (MODE == 1) {
            float* hb = (u.pm < 32) ? hmain : (hx - (size_t)NPR * DM);
            const int col0 = u.pn * 256 + wc * 32 + 4 * fq;
#pragma unroll
            for (int ai = 0; ai < 2; ++ai)
#pragma unroll
                for (int m = 0; m < 4; ++m) {
                    const int row = row0 + ai * 128 + m * 16; float ss = 0.f;
#pragma unroll
                    for (int bj = 0; bj < 2; ++bj)
#pragma unroll
                        for (int n = 0; n < 2; ++n) {
                            const int col = col0 + bj * 128 + n * 16;
                            float* hp = hb + (size_t)row * DM + col;
                            f32x4 hv = *(const f32x4*)hp + acc[ai][bj][m][n] * scale;
                            *(f32x4*)hp = hv;
                            if (gvec) {
                                const f32x4 g = *(const f32x4*)(gvec + col);
                                ss += (hv[0] * hv[0] + hv[1] * hv[1]) + (hv[2] * hv[2] + hv[3] * hv[3]);
                                *(u32x2*)(outb + (size_t)row * DM + col) = pack4(hv * g);
                            }
                        }
                    if (gvec) {
                        ss += __shfl_xor(ss, 16); ss += __shfl_xor(ss, 32);
                        if (fq == 0) part_out[(size_t)row * 32 + u.pn * 4 + wc] = ss;
                    }
                }
        } else if constexpr (MODE == 2) {
            const int col0 = u.pn * 256 + wc * 32 + 4 * fq;
#pragma unroll
            for (int ai = 0; ai < 2; ++ai)
#pragma unroll
                for (int m = 0; m < 4; ++m) {
                    const int row = row0 + ai * 128 + m * 16; const float rs = rstd_of(part_in, row);
#pragma unroll
                    for (int bj = 0; bj < 2; ++bj)
#pragma unroll
                        for (int n = 0; n < 2; ++n) {
                            const int col = col0 + bj * 128 + n * 16;
                            if (col < UW) *(u32x2*)(outb + (size_t)row * UW + col) = pack4(acc[ai][bj][m][n] * rs);
                        }
                }
        } else {
            const int col0 = u.pn * 256 + wc * 32 + 4 * fq;
            const int uoff = (MODE == 3) ? U_GA : U_GB, boff = (MODE == 3) ? 0 : DM;
#pragma unroll
            for (int ai = 0; ai < 2; ++ai)
#pragma unroll
                for (int m = 0; m < 4; ++m) {
                    const int row = row0 + ai * 128 + m * 16;
#pragma unroll
                    for (int bj = 0; bj < 2; ++bj)
#pragma unroll
                        for (int n = 0; n < 2; ++n) {
                            const int col = col0 + bj * 128 + n * 16;
                            const u32x2 gw = *(const u32x2*)(U + (size_t)row * UW + uoff + col);
                            const f32x4 gb = *(const f32x4*)(gbias + boff + col);
                            f32x4 v; const f32x4 a = acc[ai][bj][m][n];
                            v[0] = sigmoidf_(bflo(gw.x) + gb[0]) * a[0]; v[1] = sigmoidf_(bfhi(gw.x) + gb[1]) * a[1];
                            v[2] = sigmoidf_(bflo(gw.y) + gb[2]) * a[2]; v[3] = sigmoidf_(bfhi(gw.y) + gb[3]) * a[3];
                            u32x2* mp = (u32x2*)(outb + (size_t)row * DM + col);
                            if constexpr (MODE == 4) { const u32x2 o = *mp; v[0] += bflo(o.x); v[1] += bfhi(o.x); v[2] += bflo(o.y); v[3] += bfhi(o.y); }
                            *mp = pack4(v);
                        }
                }
        }
    }
};

template <int MODE> __device__ __forceinline__ void run_gemm(PG8_LAS unsigned char* lds, const bf16_t* A, const bf16_t* Bt, int N, int K, const Epi<MODE>& E) {
    pg8::Gemm g; g.A = A; g.Bt = Bt; g.M = RT; g.N = N; g.K = K;
    pg8::StaticOrder S; S.init(RT, N, (int)gridDim.x, (int)blockIdx.x);
    pg8::gemm_phase<Epi<MODE>, pg8::StaticOrder, false>(lds, g, S, E, nullptr);
}

template <int KIND> __device__ __forceinline__ int srccol(int np) {
    if constexpr (KIND == 0) return np;
    else if constexpr (KIND == 1) { const int g = np >> 5, n = (np >> 4) & 1, i = np & 15; return n * FF + 16 * g + i; }
    else { if (np < 3072) return np; if (np < 8704) return np + 16; if (np < 8720) return 3072 + (np - 8704); return -1; }
}
template <int KIND> __device__ __forceinline__ void transpose_item(const float* W, int K, int N, int NP, bf16_t* WT, float* scr, int item, int lane) {
    const int nblk = NP / 32, kb = item / nblk, nb = item % nblk, k0 = 64 * kb, n0 = 32 * nb;
    const int c = srccol<KIND>(n0 + (lane & 31));
#pragma unroll 8
    for (int i = 0; i < 32; ++i) { const int kk = 2 * i + (lane >> 5); scr[kk * 33 + (lane & 31)] = (c >= 0) ? W[(size_t)(k0 + kk) * N + c] : 0.f; }
    asm volatile("s_waitcnt lgkmcnt(0)" ::: "memory");
    const int c8 = lane & 7;
#pragma unroll
    for (int j = 0; j < 4; ++j) { const int n = (lane >> 3) + 8 * j; const float* s = scr + (8 * c8) * 33 + n;
        u32x4 o; o.x = cvt_pk_bf16(s[0 * 33], s[1 * 33]); o.y = cvt_pk_bf16(s[2 * 33], s[3 * 33]); o.z = cvt_pk_bf16(s[4 * 33], s[5 * 33]); o.w = cvt_pk_bf16(s[6 * 33], s[7 * 33]);
        *(u32x4*)(WT + (size_t)(n0 + n) * K + k0 + 8 * c8) = o; }
    asm volatile("s_waitcnt lgkmcnt(0)" ::: "memory");
}

__device__ __forceinline__ void phase_pre(const Params& p, unsigned char* smem) {
    const int tid = threadIdx.x, lane = tid & 63, wave = tid >> 6;
    const int gw = blockIdx.x * 8 + wave, NGW = gridDim.x * 8;
    float* scr = (float*)(smem + wave * 8704);
    unsigned char* ws = p.ws;
    constexpr int I_1IN = 32 * 352, I_1OUT = 88 * 64, I_IN = 32 * 280, I_GO = 16 * 64, I_OUT = 32 * 64;
    constexpr int NITEMS = 2 * I_1IN + 2 * I_1OUT + I_IN + 2 * I_GO + I_OUT;
    for (int it = gw; it < NITEMS; it += NGW) {
        int r = it;
        if (r < I_1IN) { transpose_item<1>(p.in[9], 2048, 11264, 11264, (bf16_t*)(ws + WS_BT1IN), scr, r, lane); continue; } r -= I_1IN;
        if (r < I_1OUT) { transpose_item<0>(p.in[10], 5632, 2048, 2048, (bf16_t*)(ws + WS_BT1OUT), scr, r, lane); continue; } r -= I_1OUT;
        if (r < I_IN) { transpose_item<2>(p.in[12], 2048, 8720, NIN_PAD, (bf16_t*)(ws + WS_BTIN), scr, r, lane); continue; } r -= I_IN;
        if (r < I_GO) { transpose_item<0>(p.in[16], 1024, 2048, 2048, (bf16_t*)(ws + WS_BTGO), scr, r, lane); continue; } r -= I_GO;
        if (r < I_GO) { transpose_item<0>(p.in[18], 1024, 2048, 2048, (bf16_t*)(ws + WS_BTSO), scr, r, lane); continue; } r -= I_GO;
        if (r < I_OUT) { transpose_item<0>(p.in[20], 2048, 2048, 2048, (bf16_t*)(ws + WS_BTOUT), scr, r, lane); continue; } r -= I_OUT;
        if (r < I_1IN) { transpose_item<1>(p.in[22], 2048, 11264, 11264, (bf16_t*)(ws + WS_BT2IN), scr, r, lane); continue; } r -= I_1IN;
        transpose_item<0>(p.in[23], 5632, 2048, 2048, (bf16_t*)(ws + WS_BT2OUT), scr, r, lane);
    }
    const float* g1 = p.in[8];
    bf16_t* A = (bf16_t*)(ws + WS_A); float* part = (float*)(ws + WS_PART); float* hx = (float*)(ws + WS_HX);
    for (int r = gw; r < RT; r += NGW) {
        const float* src = r < NPR ? p.in[0] + (size_t)r * DM : r < R_SAMP ? p.in[7] + (size_t)(r - R_META) * DM : r < R_SAMP + 32 ? p.in[1] + (size_t)(r - R_SAMP) * DM : nullptr;
        float* hd = r < NPR ? p.out + O_YP + (size_t)r * DM : hx + (size_t)(r - NPR) * DM;
        f32x4 v[8]; float s = 0.f;
#pragma unroll
        for (int j = 0; j < 8; ++j) { v[j] = src ? ((const f32x4*)src)[lane + 64 * j] : (f32x4){0.f, 0.f, 0.f, 0.f}; s += (v[j][0] * v[j][0] + v[j][1] * v[j][1]) + (v[j][2] * v[j][2] + v[j][3] * v[j][3]); }
        const float tot = wave_sum(s);
#pragma unroll
        for (int j = 0; j < 8; ++j) { ((f32x4*)hd)[lane + 64 * j] = v[j]; const f32x4 g = ((const f32x4*)g1)[lane + 64 * j];
            *(u32x2*)(A + (size_t)r * DM + 4 * (lane + 64 * j)) = pack4(v[j] * g); }
        if (lane < 32) part[(size_t)r * 32 + lane] = (lane == 0) ? tot : 0.f;
    }
}

__device__ __forceinline__ void gla_prompt_unit(const Params& p, unsigned char* smem, int unit) {
    const int tid = threadIdx.x, lane = tid & 63, w = tid >> 6, fr = lane & 15, fq = lane >> 4;
    const int b = unit >> 5, h = (unit >> 3) & 3, dvs = unit & 7;
    float* Bc = (float*)smem;
    bf16_t* Qt = (bf16_t*)(smem + 32768);
    bf16_t* Kt = Qt + 64 * 136;
    bf16_t* KhT = Kt + 64 * 136;
    bf16_t* VT = KhT + 128 * 72;
    bf16_t* ATT = VT + 32 * 72;
    bf16_t* ST = ATT + 64 * 72;
    float* GAD = (float*)(ST + 32 * 136);
    float* TOT = GAD + 64 * 16;
    const bf16_t* U = (const bf16_t*)(p.ws + WS_UH);
    bf16_t* Og = (bf16_t*)(p.ws + WS_OG);
    const int d1 = tid & 127, tg = tid >> 7;
    float aup[16];
#pragma unroll
    for (int r = 0; r < 16; ++r) aup[r] = p.in[13][r * 512 + h * 128 + d1];
    const float bias1 = p.in[14][h * 128 + d1];
    f32x4 Sacc[2] = {(f32x4){0.f, 0.f, 0.f, 0.f}, (f32x4){0.f, 0.f, 0.f, 0.f}};
    const int t8 = tid >> 3, p8 = tid & 7;
    __syncthreads();
    for (int c = -1; c < 32; ++c) {
        const bool meta = c < 0; const int nvalid = meta ? 16 : 64; const int row0 = meta ? R_META : b * 2048 + 64 * c;
        {
            const bool ok = t8 < nvalid; const bf16_t* ur = U + (size_t)(row0 + t8) * UW;
            const unsigned gw = ok ? *(const unsigned*)(ur + U_GAD + 2 * p8) : 0u;
            GAD[t8 * 16 + 2 * p8] = bflo(gw); GAD[t8 * 16 + 2 * p8 + 1] = bfhi(gw);
            u32x2 vw = ok ? *(const u32x2*)(ur + U_GV + h * 256 + dvs * 32 + 4 * p8) : (u32x2){0u, 0u};
            VT[(4 * p8 + 0) * 72 + t8] = (bf16_t)(vw.x & 0xffffu); VT[(4 * p8 + 1) * 72 + t8] = (bf16_t)(vw.x >> 16);
            VT[(4 * p8 + 2) * 72 + t8] = (bf16_t)(vw.y & 0xffffu); VT[(4 * p8 + 3) * 72 + t8] = (bf16_t)(vw.y >> 16);
        }
        float kc[16];
#pragma unroll
        for (int i = 0; i < 16; ++i) { const int t = tg * 16 + i; kc[i] = (t < nvalid) ? bf2f(U[(size_t)(row0 + t) * UW + U_GK + h * 128 + d1]) : 0.f; }
        __syncthreads();
        float bl[16]; float run = 0.f;
#pragma unroll
        for (int i = 0; i < 16; ++i) { const int t = tg * 16 + i; float x = bias1;
#pragma unroll
            for (int r = 0; r < 16; ++r) x += GAD[t * 16 + r] * aup[r];
            const float lg = (t < nvalid) ? logsigf_(x) * (1.f / 16.f) : 0.f; run += lg; bl[i] = run; }
        TOT[tg * 128 + d1] = run;
        __syncthreads();
        {
            float pre = 0.f, blast = 0.f;
#pragma unroll
            for (int g = 0; g < 4; ++g) { const float tv = TOT[g * 128 + d1]; blast += tv; if (g < tg) pre += tv; }
            float kh[16];
#pragma unroll
            for (int i = 0; i < 16; ++i) { bl[i] += pre; Bc[(tg * 16 + i) * 128 + d1] = bl[i]; kh[i] = kc[i] * __expf(blast - bl[i]); }
            u32x4 o0, o1;
            o0.x = cvt_pk_bf16(kh[0], kh[1]); o0.y = cvt_pk_bf16(kh[2], kh[3]); o0.z = cvt_pk_bf16(kh[4], kh[5]); o0.w = cvt_pk_bf16(kh[6], kh[7]);
            o1.x = cvt_pk_bf16(kh[8], kh[9]); o1.y = cvt_pk_bf16(kh[10], kh[11]); o1.z = cvt_pk_bf16(kh[12], kh[13]); o1.w = cvt_pk_bf16(kh[14], kh[15]);
            *(u32x4*)(KhT + d1 * 72 + tg * 16) = o0; *(u32x4*)(KhT + d1 * 72 + tg * 16 + 8) = o1;
        }
        __syncthreads();
        if (!meta) {
            {
                const int d0 = p8 * 16; const bf16_t* ur = U + (size_t)(row0 + t8) * UW + h * 128 + d0;
                const u32x4 q0 = *(const u32x4*)(ur + U_GQ), q1 = *(const u32x4*)(ur + U_GQ + 8), k0 = *(const u32x4*)(ur + U_GK), k1 = *(const u32x4*)(ur + U_GK + 8);
                const unsigned qw[8] = {q0.x, q0.y, q0.z, q0.w, q1.x, q1.y, q1.z, q1.w}, kw[8] = {k0.x, k0.y, k0.z, k0.w, k1.x, k1.y, k1.z, k1.w};
                unsigned qo[8], ko[8];
#pragma unroll
                for (int e = 0; e < 8; ++e) {
                    const float b0 = Bc[t8 * 128 + d0 + 2 * e], b1 = Bc[t8 * 128 + d0 + 2 * e + 1];
                    qo[e] = cvt_pk_bf16(bflo(qw[e]) * 0.08838834764831845f * __expf(b0), bfhi(qw[e]) * 0.08838834764831845f * __expf(b1));
                    ko[e] = cvt_pk_bf16(bflo(kw[e]) * __expf(-b0), bfhi(kw[e]) * __expf(-b1));
                }
                *(u32x4*)(Qt + t8 * 136 + d0) = (u32x4){qo[0], qo[1], qo[2], qo[3]}; *(u32x4*)(Qt + t8 * 136 + d0 + 8) = (u32x4){qo[4], qo[5], qo[6], qo[7]};
                *(u32x4*)(Kt + t8 * 136 + d0) = (u32x4){ko[0], ko[1], ko[2], ko[3]}; *(u32x4*)(Kt + t8 * 136 + d0 + 8) = (u32x4){ko[4], ko[5], ko[6], ko[7]};
            }
            __syncthreads();
            {
                const int tt = w >> 1;
#pragma unroll
                for (int si = 0; si < 2; ++si) {
                    const int st = 2 * (w & 1) + si; f32x4 acc = {0.f, 0.f, 0.f, 0.f};
                    if (st <= tt) {
#pragma unroll
                        for (int kk = 0; kk < 4; ++kk) {
                            const bf16x8 a = *(const bf16x8*)(Kt + (16 * st + fr) * 136 + 8 * fq + 32 * kk);
                            const bf16x8 bq = *(const bf16x8*)(Qt + (16 * tt + fr) * 136 + 8 * fq + 32 * kk);
                            acc = mfma16(a, bq, acc);
                        }
                        if (st == tt) {
#pragma unroll
                            for (int r = 0; r < 4; ++r) if (4 * fq + r > fr) acc[r] = 0.f;
                        }
                    }
                    *(u32x2*)(ATT + (16 * tt + fr) * 72 + 16 * st + 4 * fq) = pack4c(acc);
                }
            }
            __syncthreads();
            {
                const int tt = w >> 1, dvt = w & 1; f32x4 acc = {0.f, 0.f, 0.f, 0.f};
#pragma unroll
                for (int kk = 0; kk < 2; ++kk) {
                    const bf16x8 a = *(const bf16x8*)(VT + (16 * dvt + fr) * 72 + 8 * fq + 32 * kk);
                    const bf16x8 bb = *(const bf16x8*)(ATT + (16 * tt + fr) * 72 + 8 * fq + 32 * kk);
                    acc = mfma16(a, bb, acc);
                }
#pragma unroll
                for (int kk = 0; kk < 4; ++kk) {
                    const bf16x8 a = *(const bf16x8*)(ST + (16 * dvt + fr) * 136 + 8 * fq + 32 * kk);
                    const bf16x8 bb = *(const bf16x8*)(Qt + (16 * tt + fr) * 136 + 8 * fq + 32 * kk);
                    acc = mfma16(a, bb, acc);
                }
                *(u32x2*)(Og + (size_t)(row0 + 16 * tt + fr) * 1024 + h * 256 + dvs * 32 + 16 * dvt + 4 * fq) = pack4c(acc);
            }
        }
        {
            float dec[4];
#pragma unroll
            for (int r = 0; r < 4; ++r) dec[r] = __expf(Bc[63 * 128 + 16 * w + 4 * fq + r]);
#pragma unroll
            for (int dvt = 0; dvt < 2; ++dvt) {
                f32x4 nw = {0.f, 0.f, 0.f, 0.f};
#pragma unroll
                for (int kk = 0; kk < 2; ++kk) {
                    const bf16x8 a = *(const bf16x8*)(KhT + (16 * w + fr) * 72 + 8 * fq + 32 * kk);
                    const bf16x8 bb = *(const bf16x8*)(VT + (16 * dvt + fr) * 72 + 8 * fq + 32 * kk);
                    nw = mfma16(a, bb, nw);
                }
#pragma unroll
                for (int r = 0; r < 4; ++r) Sacc[dvt][r] = Sacc[dvt][r] * dec[r] + nw[r];
            }
        }
        __syncthreads();
#pragma unroll
        for (int dvt = 0; dvt < 2; ++dvt) *(u32x2*)(ST + (16 * dvt + fr) * 136 + 16 * w + 4 * fq) = pack4c(Sacc[dvt]);
    }
    float* pg = p.out + O_PGLA + (size_t)((b * 4 + h) * 128) * 256 + dvs * 32;
#pragma unroll
    for (int dvt = 0; dvt < 2; ++dvt)
#pragma unroll
        for (int r = 0; r < 4; ++r) pg[(size_t)(16 * w + 4 * fq + r) * 256 + 16 * dvt + fr] = Sacc[dvt][r];
    __syncthreads();
}

__device__ __forceinline__ void swa_prompt_unit(const Params& p, unsigned char* smem, int unit) {
    const int tid = threadIdx.x, lane = tid & 63, w = tid >> 6, fr = lane & 15, fq = lane >> 4;
    const int b = unit >> 6, kvh = (unit >> 4) & 3, n = unit & 15;
    bf16_t* Ks = (bf16_t*)smem;
    bf16_t* VT = Ks + 272 * 72;
    const bf16_t* U = (const bf16_t*)(p.ws + WS_UH);
    bf16_t* O = (bf16_t*)(p.ws + WS_O);
    __syncthreads();
    for (int idx = tid; idx < 272 * 8; idx += 512) {
        const int sl = idx >> 3, c8 = idx & 7;
        int row; bool ok = true;
        if (sl < 16) row = R_META + sl; else { const int pos = n * 128 + (sl - 16) - 128; ok = pos >= 0; row = b * 2048 + pos; }
        u32x4 kv = {0u, 0u, 0u, 0u}, vv = {0u, 0u, 0u, 0u};
        if (ok) { const bf16_t* ur = U + (size_t)row * UW + kvh * 64 + 8 * c8; kv = *(const u32x4*)(ur + U_SK); vv = *(const u32x4*)(ur + U_SV); }
        *(u32x4*)(Ks + sl * 72 + 8 * c8) = kv;
        bf16_t* vt = VT + (8 * c8) * 280 + sl;
        vt[0 * 280] = (bf16_t)(vv.x & 0xffffu); vt[1 * 280] = (bf16_t)(vv.x >> 16); vt[2 * 280] = (bf16_t)(vv.y & 0xffffu); vt[3 * 280] = (bf16_t)(vv.y >> 16);
        vt[4 * 280] = (bf16_t)(vv.z & 0xffffu); vt[5 * 280] = (bf16_t)(vv.z >> 16); vt[6 * 280] = (bf16_t)(vv.w & 0xffffu); vt[7 * 280] = (bf16_t)(vv.w >> 16);
    }
    __syncthreads();
    const int qt = w;
    for (int g = 0; g < 4; ++g) {
        const int head = kvh * 4 + g;
        const float slope = exp2f(-0.5f * (float)(head + 1)), sink = p.in[17][head];
        const int qrow = b * 2048 + n * 128 + 16 * qt + fr;
        const bf16_t* qp = U + (size_t)qrow * UW + U_SQ + head * 64 + 8 * fq;
        const bf16x8 qf0 = *(const bf16x8*)qp, qf1 = *(const bf16x8*)(qp + 32);
        f32x4 sc[10];
        float mx = -1e30f;
#pragma unroll
        for (int T = 0; T < 10; ++T) {
            const int slot0 = (T == 0) ? 0 : 16 + 16 * (qt + T - 1);
            f32x4 acc = {0.f, 0.f, 0.f, 0.f};
            acc = mfma16(*(const bf16x8*)(Ks + (slot0 + fr) * 72 + 8 * fq), qf0, acc);
            acc = mfma16(*(const bf16x8*)(Ks + (slot0 + fr) * 72 + 8 * fq + 32), qf1, acc);
#pragma unroll
            for (int r = 0; r < 4; ++r) {
                float s = acc[r] * 0.125f;
                if (T > 0) {
                    const int j = 16 * (qt + T - 1) + 4 * fq + r, i = 16 * qt + fr, dist = i + 128 - j;
                    const bool valid = (dist >= 0) && (dist < 128) && (n * 128 + j - 128 >= 0);
                    s = valid ? s - slope * (float)dist : -1e30f;
                }
                acc[r] = s; mx = fmaxf(mx, s);
            }
            sc[T] = acc;
        }
        mx = fmaxf(mx, __shfl_xor(mx, 16)); mx = fmaxf(mx, __shfl_xor(mx, 32)); mx = fmaxf(mx, sink);
        float sum = 0.f;
#pragma unroll
        for (int T = 0; T < 10; ++T)
#pragma unroll
            for (int r = 0; r < 4; ++r) { const float e = __expf(sc[T][r] - mx); sc[T][r] = e; sum += e; }
        sum += __shfl_xor(sum, 16); sum += __shfl_xor(sum, 32);
        const float inv = 1.f / (sum + __expf(sink - mx));
        f32x4 oacc[4] = {(f32x4){0.f, 0.f, 0.f, 0.f}, (f32x4){0.f, 0.f, 0.f, 0.f}, (f32x4){0.f, 0.f, 0.f, 0.f}, (f32x4){0.f, 0.f, 0.f, 0.f}};
#pragma unroll
        for (int pp = 0; pp < 5; ++pp) {
            const int T0 = 2 * pp, T1 = 2 * pp + 1;
            const int s0 = (T0 == 0) ? 0 : 16 + 16 * (qt + T0 - 1), s1 = 16 + 16 * (qt + T1 - 1);
            const u32x2 pa = pack4(sc[T0]), pb = pack4(sc[T1]);
            const u32x4 pw = {pa.x, pa.y, pb.x, pb.y};
            bf16x8 pf; __builtin_memcpy(&pf, &pw, 16);
#pragma unroll
            for (int dvt = 0; dvt < 4; ++dvt) {
                const u32x2 va = *(const u32x2*)(VT + (16 * dvt + fr) * 280 + s0 + 4 * fq), vb = *(const u32x2*)(VT + (16 * dvt + fr) * 280 + s1 + 4 * fq);
                const u32x4 vw = {va.x, va.y, vb.x, vb.y};
                bf16x8 vf; __builtin_memcpy(&vf, &vw, 16);
                oacc[dvt] = mfma16(vf, pf, oacc[dvt]);
            }
        }
#pragma unroll
        for (int dvt = 0; dvt < 4; ++dvt) *(u32x2*)(O + (size_t)qrow * 1024 + head * 64 + 16 * dvt + 4 * fq) = pack4(oacc[dvt] * inv);
    }
    __syncthreads();
}

__device__ __forceinline__ void gla_sample_unit(const Params& p, unsigned char* smem, int unit) {
    const int tid = threadIdx.x; const int i = unit >> 2, h = unit & 3, row = R_SAMP + i;
    float* eg = (float*)smem; float* qt = eg + 128; float* kk = qt + 128; float* vv = kk + 128; float* red = vv + 256; float* red2 = red + 128;
    const bf16_t* ur = (const bf16_t*)(p.ws + WS_UH) + (size_t)row * UW;
    bf16_t* Og = (bf16_t*)(p.ws + WS_OG);
    __syncthreads();
    if (tid < 128) {
        const int d = tid; float x = p.in[14][h * 128 + d];
#pragma unroll
        for (int r = 0; r < 16; ++r) x += bf2f(ur[U_GAD + r]) * p.in[13][r * 512 + h * 128 + d];
        const float lg = logsigf_(x) * (1.f / 16.f), e = __expf(lg);
        const float q = bf2f(ur[U_GQ + h * 128 + d]) * 0.08838834764831845f, k = bf2f(ur[U_GK + h * 128 + d]);
        eg[d] = e; qt[d] = q * e; kk[d] = k; red[d] = q * k;
    } else if (tid < 384) { const int dv = tid - 128; vv[dv] = bf2f(ur[U_GV + h * 256 + dv]); }
    __syncthreads();
    float qk = 0.f;
    for (int d = 0; d < 128; ++d) qk += red[d];
    const int dv = tid & 255, half = tid >> 8;
    const float* s0p = p.in[6] + (size_t)((i * 4 + h) * 128) * 256 + dv;
    float* snp = p.out + O_SGLA + (size_t)((i * 4 + h) * 128) * 256 + dv;
    const float v = vv[dv]; float op = 0.f;
#pragma unroll 4
    for (int d = half * 64; d < half * 64 + 64; ++d) { const float s0 = s0p[(size_t)d * 256]; snp[(size_t)d * 256] = s0 * eg[d] + kk[d] * v; op += qt[d] * s0; }
    red2[tid] = op;
    __syncthreads();
    if (half == 0) { const float o = red2[tid] + red2[tid + 256] + qk * v; Og[(size_t)row * 1024 + h * 256 + dv] = f2bf(o); }
    __syncthreads();
}

__device__ __forceinline__ void swa_sample_unit(const Params& p, unsigned char* smem, int unit) {
    const int tid = threadIdx.x, lane = tid & 63, w = tid >> 6; const int i = unit >> 2, kvh = unit & 3, row = R_SAMP + i;
    float* qv = (float*)smem; float* knew = qv + 256; float* vnew = knew + 64; float* sc = vnew + 64; float* invd = sc + 4 * 144; float* red2 = invd + 4;
    const bf16_t* ur = (const bf16_t*)(p.ws + WS_UH) + (size_t)row * UW;
    bf16_t* O = (bf16_t*)(p.ws + WS_O);
    const float* cmk = p.in[2]; const float* cmv = p.in[3]; const float* cwk = p.in[4]; const float* cwv = p.in[5];
    __syncthreads();
    if (tid < 256) qv[tid] = bf2f(ur[U_SQ + kvh * 256 + tid]) * 0.125f;
    else if (tid < 320) knew[tid - 256] = bf2f(ur[U_SK + kvh * 64 + (tid - 256)]);
    else if (tid < 384) vnew[tid - 320] = bf2f(ur[U_SV + kvh * 64 + (tid - 320)]);
    __syncthreads();
    for (int idx = tid; idx < 576; idx += 512) {
        const int g = idx / 144, key = idx % 144; const float slope = exp2f(-0.5f * (float)(kvh * 4 + g + 1));
        float s = 0.f, biasv = 0.f;
        if (key == 143) { for (int c = 0; c < 64; ++c) s += qv[g * 64 + c] * knew[c]; }
        else {
            const float* kp;
            if (key < 16) kp = cmk + (size_t)((i * 16 + key) * 4 + kvh) * 64;
            else { const int c = key - 15; kp = cwk + (size_t)((i * 128 + c) * 4 + kvh) * 64; biasv = slope * (float)(128 - c); }
#pragma unroll 4
            for (int c4 = 0; c4 < 16; ++c4) { const f32x4 kvv = ((const f32x4*)kp)[c4]; const float* q4 = qv + g * 64 + 4 * c4;
                s += (q4[0] * kvv[0] + q4[1] * kvv[1]) + (q4[2] * kvv[2] + q4[3] * kvv[3]); }
        }
        sc[g * 144 + key] = s - biasv;
    }
    __syncthreads();
    if (w < 4) {
        const int g = w; const float sink = p.in[17][kvh * 4 + g];
        float m = -1e30f;
        for (int key = lane; key < 144; key += 64) m = fmaxf(m, sc[g * 144 + key]);
        m = fmaxf(wave_max(m), sink);
        float sum = 0.f;
        for (int key = lane; key < 144; key += 64) { const float e = __expf(sc[g * 144 + key] - m); sc[g * 144 + key] = e; sum += e; }
        sum = wave_sum(sum);
        if (lane == 0) invd[g] = 1.f / (sum + __expf(sink - m));
    }
    __syncthreads();
    {
        const int g = (tid >> 6) & 3, dv = tid & 63, half = tid >> 8; float op = 0.f;
        for (int key = half * 72; key < half * 72 + 72; ++key) {
            float vval;
            if (key == 143) vval = vnew[dv];
            else if (key < 16) vval = cmv[(size_t)((i * 16 + key) * 4 + kvh) * 64 + dv];
            else vval = cwv[(size_t)((i * 128 + (key - 15)) * 4 + kvh) * 64 + dv];
            op += sc[g * 144 + key] * vval;
        }
        red2[tid] = op;
    }
    __syncthreads();
    if (tid < 256) { const int g = tid >> 6, dv = tid & 63; O[(size_t)row * 1024 + (kvh * 4 + g) * 64 + dv] = f2bf((red2[tid] + red2[tid + 256]) * invd[g]); }
    float* owk = p.out + O_SWK; float* owv = p.out + O_SWV;
    for (int idx = tid; idx < 128 * 64; idx += 512) {
        const int c = idx >> 6, e = idx & 63; const size_t di = (size_t)((i * 128 + c) * 4 + kvh) * 64 + e;
        if (c < 127) { const size_t si = (size_t)((i * 128 + c + 1) * 4 + kvh) * 64 + e; owk[di] = cwk[si]; owv[di] = cwv[si]; }
        else { owk[di] = knew[e]; owv[di] = vnew[e]; }
    }
    __syncthreads();
}

__device__ __forceinline__ void phase_mixer(const Params& p, unsigned char* smem) {
    const int G = gridDim.x, bid = blockIdx.x;
    for (int u = bid; u < 128; u += G) gla_prompt_unit(p, smem, u);
    const bool split = G >= 256;
    if (split && bid < 128) return;
    const int vb = split ? bid - 128 : bid, nb = split ? G - 128 : G;
    for (int u = vb; u < 256; u += nb) swa_prompt_unit(p, smem, u);
    for (int u = vb; u < 128; u += nb) gla_sample_unit(p, smem, u);
    for (int u = vb; u < 128; u += nb) swa_sample_unit(p, smem, u);
}

__device__ __forceinline__ void phase_gnorm(const Params& p) {
    const int tid = threadIdx.x, lane = tid & 63, wave = tid >> 6;
    const int gw = blockIdx.x * 8 + wave, NGW = gridDim.x * 8;
    const bf16_t* U = (const bf16_t*)(p.ws + WS_UH); bf16_t* Og = (bf16_t*)(p.ws + WS_OG); const float* onorm = p.in[15];
    for (int ri = gw; ri < NPR + 32; ri += NGW) {
        const int row = ri < NPR ? ri : R_SAMP + (ri - NPR);
#pragma unroll
        for (int hh = 0; hh < 4; ++hh) {
            const int col = hh * 256 + 4 * lane;
            u32x2* op = (u32x2*)(Og + (size_t)row * 1024 + col);
            const u32x2 ow = *op; const u32x2 gw2 = *(const u32x2*)(U + (size_t)row * UW + U_GR + col);
            const f32x4 on = *(const f32x4*)(onorm + col);
            const float o0 = bflo(ow.x), o1 = bfhi(ow.x), o2 = bflo(ow.y), o3 = bfhi(ow.y);
            const float ss = wave_sum((o0 * o0 + o1 * o1) + (o2 * o2 + o3 * o3));
            const float rs = rsqrtf(ss * (1.f / 256.f) + EPSV);
            f32x4 v; v[0] = o0 * rs * on[0] * siluf_(bflo(gw2.x)); v[1] = o1 * rs * on[1] * siluf_(bfhi(gw2.x));
            v[2] = o2 * rs * on[2] * siluf_(bflo(gw2.y)); v[3] = o3 * rs * on[3] * siluf_(bfhi(gw2.y));
            *op = pack4(v);
        }
    }
    const int gt = blockIdx.x * 512 + tid, NT = gridDim.x * 512;
    for (int idx = gt; idx < 2 * 16384 + 2 * 131072; idx += NT) {
        if (idx < 32768) { const int which = idx >> 14, r = idx & 16383, m = (r >> 8) & 15, col = r & 255;
            p.out[(which ? O_PMV : O_PMK) + r] = bf2f(U[(size_t)(R_META + m) * UW + (which ? U_SV : U_SK) + col]); }
        else { const int r2 = idx - 32768, which = r2 >> 17, r = r2 & 131071, b = r >> 15, j = (r >> 8) & 127, col = r & 255;
            p.out[(which ? O_PWV : O_PWK) + r] = bf2f(U[(size_t)(b * 2048 + 1920 + j) * UW + (which ? U_SV : U_SK) + col]); }
    }
}

__device__ __forceinline__ void phase_final(const Params& p) {
    const int tid = threadIdx.x, lane = tid & 63, wave = tid >> 6;
    const int gw = blockIdx.x * 8 + wave, NGW = gridDim.x * 8;
    const float* fn = p.in[24]; const float* hx = (const float*)(p.ws + WS_HX);
    for (int ri = gw; ri < NPR + 32; ri += NGW) {
        const float* src = ri < NPR ? p.out + O_YP + (size_t)ri * DM : hx + (size_t)(R_SAMP - NPR + (ri - NPR)) * DM;
        float* dst = ri < NPR ? p.out + O_YP + (size_t)ri * DM : p.out + O_YS + (size_t)(ri - NPR) * DM;
        f32x4 v[8]; float s = 0.f;
#pragma unroll
        for (int j = 0; j < 8; ++j) { v[j] = ((const f32x4*)src)[lane + 64 * j]; s += (v[j][0] * v[j][0] + v[j][1] * v[j][1]) + (v[j][2] * v[j][2] + v[j][3] * v[j][3]); }
        const float rs = rsqrtf(wave_sum(s) * (1.f / 2048.f) + EPSV);
#pragma unroll
        for (int j = 0; j < 8; ++j) ((f32x4*)dst)[lane + 64 * j] = v[j] * rs * ((const f32x4*)fn)[lane + 64 * j];
    }
}

typedef const __attribute__((address_space(4))) Params* KParams;
__global__ void __launch_bounds__(512, 2) mega_fwd(Params p_arg) {
    extern __shared__ __attribute__((aligned(16))) unsigned char smem[];
    cg::grid_group grid = cg::this_grid();
    const int ph_lo = p_arg.ph_lo, ph_hi = p_arg.ph_hi;
#ifndef PHMASK
#define PHMASK 0x7ff
#endif
#define PHASE(n, ...) if constexpr ((PHMASK >> (n)) & 1) if (ph_lo <= (n) && (n) < ph_hi) { if ((n) > ph_lo) grid.sync(); \
        KParams kp = (KParams)__builtin_amdgcn_kernarg_segment_ptr(); asm volatile("" : "+s"(kp) :: "memory"); const Params& p = *(const Params*)kp; \
        PG8_LAS unsigned char* lds = (PG8_LAS unsigned char*)smem; unsigned char* ws = p.ws; (void)lds; (void)ws; \
        bf16_t* Abuf = (bf16_t*)(ws + WS_A); bf16_t* UH = (bf16_t*)(ws + WS_UH); bf16_t* Og = (bf16_t*)(ws + WS_OG); bf16_t* Ob = (bf16_t*)(ws + WS_O); \
        float* part = (float*)(ws + WS_PART); float* hx = (float*)(ws + WS_HX); float* hmain = p.out + O_YP; (void)Abuf; (void)UH; (void)Og; (void)Ob; (void)part; (void)hx; (void)hmain; \
        __VA_ARGS__ }
    PHASE(0, phase_pre(p, smem);)
    PHASE(1, Epi<0> E{}; E.outb = UH; E.part_in = part; run_gemm<0>(lds, Abuf, (const bf16_t*)(ws + WS_BT1IN), 11264, 2048, E);)
    PHASE(2, Epi<1> E{}; E.outb = Abuf; E.hmain = hmain; E.hx = hx; E.part_out = part; E.gvec = p.in[11]; E.scale = 0.5f; run_gemm<1>(lds, UH, (const bf16_t*)(ws + WS_BT1OUT), 2048, 5632, E);)
    PHASE(3, Epi<2> E{}; E.outb = UH; E.part_in = part; run_gemm<2>(lds, Abuf, (const bf16_t*)(ws + WS_BTIN), NIN_PAD, 2048, E);)
    PHASE(4, phase_mixer(p, smem);)
#ifdef DBG_COPY
    PHASE(5, { const bf16_t* src = (DBG_COPY == 1) ? Og : Ob; for (size_t i = (size_t)blockIdx.x * 512 + threadIdx.x; i < (size_t)8192 * 1024; i += (size_t)gridDim.x * 512) p.out[i] = bf2f(src[i]); })
#else
    PHASE(5, phase_gnorm(p);)
#endif
    PHASE(6, Epi<3> E3{}; E3.outb = Abuf; E3.U = UH; E3.gbias = p.in[19]; run_gemm<3>(lds, Og, (const bf16_t*)(ws + WS_BTGO), 2048, 1024, E3);
             Epi<4> E4{}; E4.outb = Abuf; E4.U = UH; E4.gbias = p.in[19]; run_gemm<4>(lds, Ob, (const bf16_t*)(ws + WS_BTSO), 2048, 1024, E4);)
    PHASE(7, Epi<1> E{}; E.outb = Og; E.hmain = hmain; E.hx = hx; E.part_out = part; E.gvec = p.in[21]; E.scale = 1.0f; run_gemm<1>(lds, Abuf, (const bf16_t*)(ws + WS_BTOUT), 2048, 2048, E);)
    PHASE(8, Epi<0> E{}; E.outb = UH; E.part_in = part; run_gemm<0>(lds, Og, (const bf16_t*)(ws + WS_BT2IN), 11264, 2048, E);)
    PHASE(9, Epi<1> E{}; E.outb = nullptr; E.hmain = hmain; E.hx = hx; E.part_out = nullptr; E.gvec = nullptr; E.scale = 0.5f; run_gemm<1>(lds, UH, (const bf16_t*)(ws + WS_BT2OUT), 2048, 5632, E);)
    PHASE(10, phase_final(p);)
#undef PHASE
}

extern "C" void kernel_launch(void* const* d_in, const int* in_sizes, int n_in, void* d_out, int out_size, void* d_ws, size_t ws_size, hipStream_t stream) {
    static int grid = 0;
    if (grid == 0) {
        if (n_in != 25 || out_size != 23953408 || ws_size < WS_END) { fprintf(stderr, "kernel_launch: unexpected shapes n_in %d out %d ws %zu (need %zu)\n", n_in, out_size, ws_size, (size_t)WS_END); grid = -1; return; }
        int dev = 0, cus = 0, per_cu = 0;
        hipGetDevice(&dev); hipDeviceGetAttribute(&cus, hipDeviceAttributeMultiprocessorCount, dev);
        if (hipFuncSetAttribute((const void*)mega_fwd, hipFuncAttributeMaxDynamicSharedMemorySize, LDS_BYTES) != hipSuccess) { fprintf(stderr, "kernel_launch: hipFuncSetAttribute failed\n"); grid = -1; return; }
        hipOccupancyMaxActiveBlocksPerMultiprocessor(&per_cu, (const void*)mega_fwd, 512, LDS_BYTES);
        if (per_cu < 1) { fprintf(stderr, "kernel_launch: occupancy query says %d blocks per CU\n", per_cu); per_cu = 1; }
        (void)hipGetLastError();
        grid = cus;
        if (grid > 256) grid = 256;
    }
    if (grid < 0) return;
    Params p{};
    for (int i = 0; i < 25; ++i) p.in[i] = (const float*)d_in[i];
    p.out = (float*)d_out; p.ws = (unsigned char*)d_ws;
#if MK_LAUNCHES == 1
    p.ph_lo = 0; p.ph_hi = NPHASE;
    void* args[] = {&p};
    hipError_t e = hipLaunchCooperativeKernel((const void*)mega_fwd, dim3(grid), dim3(512), args, LDS_BYTES, stream);
    if (e != hipSuccess) fprintf(stderr, "cooperative launch failed: %s (grid %d)\n", hipGetErrorString(e), grid);
#else
    for (int ph = 0; ph < NPHASE; ++ph) { p.ph_lo = ph; p.ph_hi = ph + 1; hipLaunchKernelGGL(mega_fwd, dim3(grid), dim3(512), LDS_BYTES, stream, p); }
#endif
}
```

```cpp
#include <hip/hip_runtime.h>
#include <hip/hip_cooperative_groups.h>
#include <cstdio>
#include <cstdint>
namespace cg = cooperative_groups;
#ifndef MK_LAUNCHES
#define MK_LAUNCHES 1
#endif
namespace pg8 {
#define PG8_LAS __attribute__((address_space(3)))
typedef unsigned short bf16_t;
typedef short bf16x8 __attribute__((ext_vector_type(8)));
typedef float f32x4 __attribute__((ext_vector_type(4)));
typedef unsigned u32x4 __attribute__((ext_vector_type(4)));
constexpr int BM = 256, BK = 64, HALF = 128, HTB = HALF * BK * 2  , STAGE_BYTES = 8 * HTB, NXCD = 8, WGM = 8;

__host__ __device__ __forceinline__ int lds_byte(int r, int c) { const int st = (r >> 4) * 2 + (c >> 5), rr = r & 15, cc = c & 31, ob = rr * 64 + cc * 2; return st * 1024 + (ob ^ (((ob >> 9) & 1) << 5)); }
__host__ __device__ __forceinline__ void stage_rc(int b, int& R, int& C) { const int st = b / 1024, sb = b % 1024, swz = sb ^ (((sb >> 9) & 1) << 5); R = (st >> 1) * 16 + swz / 64; C = (st & 1) * 32 + (swz % 64) / 2; }
__host__ __device__ __forceinline__ int perm32(int rho) { const int n = rho >> 4, i = rho & 15; return 8 * (i >> 2) + 4 * n + (i & 3); }
struct Unit { int pm, pn; };
struct Gemm { const bf16_t* A; const bf16_t* Bt; int M, N, K; };

struct StaticOrder {
    int nM, nN, nwg, G, c;
    __host__ __device__ void init(int M, int N, int G_, int c_) { nM = M / BM; nN = N / BM; nwg = nM * nN; G = G_; c = c_; }
    __host__ __device__ bool next(int i, Unit& u) const {
        const long L = (long)i * G + c; if (L >= nwg) return false;
        int wgid = (int)L; { const int q = nwg / NXCD, r = nwg % NXCD, xcd = wgid % NXCD, off = wgid / NXCD; wgid = (xcd < r ? xcd * (q + 1) : r * (q + 1) + (xcd - r) * q) + off; }
        const int nig = WGM * nN, gid = wgid / nig, fm = gid * WGM, gsz = (nM - fm) < WGM ? (nM - fm) : WGM;
        u.pm = fm + ((wgid % nig) % gsz); u.pn = (wgid % nig) / gsz; return true;
    }
    __device__ __forceinline__ void a_ready(const Unit&) const {}
    __device__ __forceinline__ void done(const Unit&) const {}
};
typedef __bf16 bf16v2_t __attribute__((ext_vector_type(2)));
typedef float f32v2_t __attribute__((ext_vector_type(2)));
__device__ __forceinline__ unsigned cvt_pk_bf16_c(float lo, float hi) { f32v2_t v = {lo, hi}; bf16v2_t b = __builtin_convertvector(v, bf16v2_t); unsigned r; __builtin_memcpy(&r, &b, 4); return r; }
__device__ __forceinline__ unsigned cvt_pk_bf16(float lo, float hi) { unsigned r; asm volatile("v_cvt_pk_bf16_f32 %0, %1, %2" : "=v"(r) : "v"(lo), "v"(hi)); return r; }
template <class Epi, class Sched, bool STAMP = false>
__device__ __forceinline__ void gemm_phase(PG8_LAS unsigned char* lds, const Gemm g, const Sched& S, const Epi& E, unsigned long long* stamps) {
    const int tid = threadIdx.x, wid = __builtin_amdgcn_readfirstlane(tid >> 6), lane = tid & 63, wr = wid >> 2, wc = wid & 3, fr = lane & 15, fq = lane >> 4;
    const int K = g.K, nt = K / BK;
    int ts_lo = 0, ts_hi = 0, nts = 0; const unsigned long long rt_entry = STAMP ? (unsigned long long)wall_clock64() : 0ull;
#define PG8_STAMP() do { if (STAMP && wid == 0 && nts < 64) { const unsigned long long _c = (unsigned long long)clock64(); \
        ts_lo = (lane == nts) ? (int)(unsigned)_c : ts_lo; ts_hi = (lane == nts) ? (int)(unsigned)(_c >> 32) : ts_hi; ++nts; } } while (0)
    PG8_STAMP();
    unsigned voffA[2], voffB[2];
#pragma unroll
    for (int i = 0; i < 2; ++i) { int R, C; stage_rc(tid * 16 + i * 8192, R, C); const int Rb = Epi::PERM ? ((R & ~31) + perm32(R & 31)) : R;
        voffA[i] = (unsigned)(R * K + C) * 2u; voffB[i] = (unsigned)(Rb * K + C) * 2u; }
    const size_t kstep = (size_t)(BK * 2);
    const size_t hstep = (size_t)HALF * K * 2;
    const size_t tstep = 2 * hstep;
    const unsigned ldsw = (unsigned)wid * 1024u;
    const int aoff = lds_byte(wr * 64 + fr, fq * 8), boff = lds_byte(wc * 32 + fr, fq * 8);
#define PG8_SA(b, h) (((b) * 2 + (h)) * HTB)
#define PG8_SB(b, h) ((4 + (b) * 2 + (h)) * HTB)
#define PG8_STAGE(bufoff, gbase, voff) do { _Pragma("unroll") for (int _i = 0; _i < 2; ++_i) \
        __builtin_amdgcn_global_load_lds((const unsigned*)((const char*)(gbase) + (voff)[_i]), (PG8_LAS unsigned*)(lds + (bufoff) + ldsw + _i * 8192), 16, 0, 0); } while (0)
#define PG8_LDA(dst, b, h) do { _Pragma("unroll") for (int m = 0; m < 4; ++m) _Pragma("unroll") for (int k = 0; k < 2; ++k) dst[m][k] = *(const PG8_LAS bf16x8*)(lds + PG8_SA(b, h) + aoff + m * 2048 + k * 1024); } while (0)
#define PG8_LDB(dst, b, h) do { _Pragma("unroll") for (int n = 0; n < 2; ++n) _Pragma("unroll") for (int k = 0; k < 2; ++k) dst[n][k] = *(const PG8_LAS bf16x8*)(lds + PG8_SB(b, h) + boff + n * 2048 + k * 1024); } while (0)
#define PG8_MMA(ai, bj, At, Bt) do { __builtin_amdgcn_s_setprio(1); _Pragma("unroll") for (int m = 0; m < 4; ++m) _Pragma("unroll") for (int n = 0; n < 2; ++n) _Pragma("unroll") for (int k = 0; k < 2; ++k) \
        acc[ai][bj][m][n] = __builtin_amdgcn_mfma_f32_16x16x32_bf16(Bt[n][k], At[m][k], acc[ai][bj][m][n], 0, 0, 0); __builtin_amdgcn_s_setprio(0); } while (0)
#define PG8_WAIT_V(n) asm volatile("s_waitcnt vmcnt(" #n ")" ::: "memory")
#define PG8_WAIT_L(n) asm volatile("s_waitcnt lgkmcnt(" #n ")" ::: "memory")
#define PG8_BAR __builtin_amdgcn_s_barrier()
#define PG8_SCHED __builtin_amdgcn_sched_barrier(0)
    Unit cur, nxt; int ui = 0;
    if (!S.next(0, cur)) return;
    f32x4 acc[2][2][4][2];
#pragma unroll
    for (int a = 0; a < 2; ++a)
#pragma unroll
        for (int b = 0; b < 2; ++b)
#pragma unroll
            for (int m = 0; m < 4; ++m)
#pragma unroll
                for (int n = 0; n < 2; ++n) acc[a][b][m][n] = (f32x4){0.f, 0.f, 0.f, 0.f};
    bf16x8 At[4][2], B0[2][2], B1[2][2];
    const char* cA = (const char*)g.A + (size_t)cur.pm * tstep; const char* cB = (const char*)g.Bt + (size_t)cur.pn * tstep;
    S.a_ready(cur);
    PG8_STAGE(PG8_SB(0, 0), cB, voffB); PG8_STAGE(PG8_SA(0, 0), cA, voffA); PG8_STAGE(PG8_SB(0, 1), cB + hstep, voffB); PG8_STAGE(PG8_SA(0, 1), cA + hstep, voffA);
    if (wr == 1) PG8_BAR;
    PG8_WAIT_V(4); PG8_BAR;
    PG8_STAGE(PG8_SB(1, 0), cB + kstep, voffB); PG8_STAGE(PG8_SA(1, 0), cA + kstep, voffA); PG8_STAGE(PG8_SB(1, 1), cB + hstep + kstep, voffB);
    PG8_WAIT_V(6); PG8_BAR;
    PG8_STAMP();
    for (;;) {
        const bool has_next = S.next(ui + 1, nxt);
        const char* nA = has_next ? (const char*)g.A + (size_t)nxt.pm * tstep : cA; const char* nB = has_next ? (const char*)g.Bt + (size_t)nxt.pn * tstep : cB;
        for (int t = 0; t < nt; t += 2) {
            const bool last = (t == nt - 2);
            const char* a1 = cA + (size_t)(t + 1) * kstep;
            const char* a2 = last ? nA : cA + (size_t)(t + 2) * kstep; const char* b2 = last ? nB : cB + (size_t)(t + 2) * kstep;
            const char* a3 = a2 + kstep; const char* b3 = b2 + kstep;
            if (last && has_next) S.a_ready(nxt);
            PG8_LDB(B0, 0, 0); PG8_SCHED; PG8_LDA(At, 0, 0); PG8_STAGE(PG8_SA(1, 1), a1 + hstep, voffA);
            PG8_WAIT_L(8); PG8_BAR; PG8_WAIT_L(0); PG8_MMA(0, 0, At, B0); PG8_BAR; PG8_SCHED;
            PG8_LDB(B1, 0, 1); PG8_STAGE(PG8_SB(0, 0), b2, voffB);
            PG8_BAR; PG8_WAIT_L(0); PG8_MMA(0, 1, At, B1); PG8_BAR;
            PG8_LDA(At, 0, 1); PG8_STAGE(PG8_SA(0, 0), a2, voffA);
            PG8_BAR; PG8_WAIT_L(0); PG8_MMA(1, 0, At, B0); PG8_BAR; PG8_SCHED;
            PG8_STAGE(PG8_SB(0, 1), b2 + hstep, voffB);
            PG8_WAIT_V(6); PG8_BAR; PG8_MMA(1, 1, At, B1); PG8_BAR;
            PG8_LDB(B0, 1, 0); PG8_SCHED; PG8_LDA(At, 1, 0); PG8_STAGE(PG8_SA(0, 1), a2 + hstep, voffA);
            PG8_WAIT_L(8); PG8_BAR; PG8_WAIT_L(0); PG8_MMA(0, 0, At, B0); PG8_BAR; PG8_SCHED;
            PG8_LDB(B1, 1, 1); PG8_STAGE(PG8_SB(1, 0), b3, voffB);
            PG8_BAR; PG8_WAIT_L(0); PG8_MMA(0, 1, At, B1); PG8_BAR;
            PG8_LDA(At, 1, 1); PG8_STAGE(PG8_SA(1, 0), a3, voffA);
            PG8_BAR; PG8_WAIT_L(0); PG8_MMA(1, 0, At, B0); PG8_BAR; PG8_SCHED;
            PG8_STAGE(PG8_SB(1, 1), b3 + hstep, voffB);
            PG8_WAIT_V(6); PG8_BAR; PG8_MMA(1, 1, At, B1); PG8_BAR;
        }
        PG8_STAMP();
        if constexpr (!Epi::AFTER_DRAIN) { E(acc, cur, wr, wc, fr, fq); S.done(cur); }
        PG8_STAMP();
        if (!has_next) break;
#pragma unroll
        for (int a = 0; a < 2; ++a)
#pragma unroll
            for (int b = 0; b < 2; ++b)
#pragma unroll
                for (int m = 0; m < 4; ++m)
#pragma unroll
                    for (int n = 0; n < 2; ++n) acc[a][b][m][n] = (f32x4){0.f, 0.f, 0.f, 0.f};
        cur = nxt; cA = nA; cB = nB; ++ui;
    }
    PG8_WAIT_V(0);
    if (wr == 0) PG8_BAR;
    PG8_BAR;
    if constexpr (Epi::AFTER_DRAIN) { E.fused(acc, cur, wr, wc, fr, fq, lds, wid, lane); S.done(cur); }
    PG8_STAMP();
    if (STAMP && wid == 0) { stamps[lane] = lane < nts ? (((unsigned long long)(unsigned)ts_hi << 32) | (unsigned)ts_lo) : 0ull;
        if (lane == 62) stamps[62] = rt_entry; if (lane == 63) stamps[63] = (unsigned long long)wall_clock64(); }
#undef PG8_STAMP
#undef PG8_SA
#undef PG8_SB
#undef PG8_STAGE
#undef PG8_LDA
#undef PG8_LDB
#undef PG8_MMA
#undef PG8_WAIT_V
#undef PG8_WAIT_L
#undef PG8_BAR
#undef PG8_SCHED
}
}

#define XB_TMO      128
#define XB_XCNT(j)  (256  + 64 * (j))
#define XB_XSUB(j)  (1280 + 64 * (j))
#define XB_XGEN(j)  (2304 + 64 * (j))
#define XB_TOP      3328
#define XB_TOPGEN   3392
#define XCD_BAR_WORDS 3456
#define XB_SPIN_CAP (1u << 18)
#define LAS __attribute__((address_space(3)))

__device__ __forceinline__ unsigned xb_ld(unsigned* p)              { return __hip_atomic_load(p, __ATOMIC_RELAXED, __HIP_MEMORY_SCOPE_AGENT); }
__device__ __forceinline__ unsigned xb_add(unsigned* p, unsigned v) { return __hip_atomic_fetch_add(p, v, __ATOMIC_RELAXED, __HIP_MEMORY_SCOPE_AGENT); }
__device__ __forceinline__ unsigned xb_xcc_id() { return (unsigned)__builtin_amdgcn_s_getreg((3 << 11) | 20) & 0xFu; }
#define XB_SPIN(cond, bar) do { unsigned _sp = 0; while (cond) { __builtin_amdgcn_s_sleep(1); \
    if ((++_sp & 255u) == 0u) { if (xb_ld(&(bar)[XB_TMO])) break; if (_sp > XB_SPIN_CAP) { atomicAdd(&(bar)[XB_TMO], 1u); break; } } } } while (0)

struct XcdBarrier {
    unsigned* bar; unsigned x;
    volatile LAS unsigned* st;
};

__device__ __forceinline__ XcdBarrier xcd_barrier_post(unsigned* bar, volatile LAS unsigned* st) {
    XcdBarrier b; b.bar = bar; b.x = xb_xcc_id(); b.st = st;
    if (threadIdx.x == 0) (void)xb_add(&bar[XB_XCNT(b.x)], 1u);
    return b;
}
__device__ __forceinline__ void xcd_barrier_complete(unsigned* bar, unsigned x, unsigned& nloc, unsigned& nx) {
    const unsigned G = gridDim.x * gridDim.y * gridDim.z;
    unsigned sum, cnt, mine, sp = 0u;
    for (;;) {
        sum = 0u; cnt = 0u; mine = 0u;
#pragma unroll
        for (unsigned j = 0; j < 16; ++j) { const unsigned c = xb_ld(&bar[XB_XCNT(j)]); sum += c; cnt += (c > 0u) ? 1u : 0u; mine = (j == x) ? c : mine; }
        if (sum == G) break;
        __builtin_amdgcn_s_sleep(1);
        if ((++sp & 255u) == 0u) { if (xb_ld(&bar[XB_TMO])) break; if (sp > XB_SPIN_CAP) { atomicAdd(&bar[XB_TMO], 1u); break; } }
    }
    nloc = mine > 0u ? mine : 1u; nx = cnt > 0u ? cnt : 1u;
}

__device__ __forceinline__ void xcd_barrier(const XcdBarrier& b) {
    asm volatile("s_waitcnt vmcnt(0)" ::: "memory");
    __syncthreads();
    if (threadIdx.x == 0) {
        unsigned* bar = b.bar;
        __builtin_amdgcn_s_waitcnt(0);
        unsigned nloc = b.st[0], nx = b.st[1];
        if (nloc == 0u) { xcd_barrier_complete(bar, b.x, nloc, nx); b.st[0] = nloc; b.st[1] = nx; }
        const unsigned old = xb_add(&bar[XB_XSUB(b.x)], 1u);
        const unsigned gen = old / nloc;
        if (old + 1u == (gen + 1u) * nloc) {
            __builtin_amdgcn_fence(__ATOMIC_RELEASE, "agent");
            asm volatile("s_waitcnt vmcnt(0)" ::: "memory");
            const unsigned og = xb_add(&bar[XB_TOP], 1u);
            const unsigned tg = og / nx;
            if (og + 1u == (tg + 1u) * nx) xb_add(&bar[XB_TOPGEN], 1u);
            else XB_SPIN(xb_ld(&bar[XB_TOPGEN]) == tg, bar);
            __builtin_amdgcn_fence(__ATOMIC_ACQUIRE, "agent");
            xb_add(&bar[XB_XGEN(b.x)], 1u);
            asm volatile("s_waitcnt vmcnt(0)" ::: "memory");
        } else {
            XB_SPIN(xb_ld(&bar[XB_XGEN(b.x)]) == gen, bar);
            __builtin_amdgcn_fence(__ATOMIC_ACQUIRE, "agent");
            asm volatile("s_waitcnt vmcnt(0)" ::: "memory");
        }
    }
    __syncthreads();
}


using pg8::bf16_t; using pg8::bf16x8; using pg8::f32x4; using pg8::u32x4; using pg8::cvt_pk_bf16;
typedef unsigned u32x2 __attribute__((ext_vector_type(2)));
constexpr int DM = 2048, FF = 5632, NPR = 8192, R_META = 8192, R_SAMP = 8208, RT = 8448;
constexpr int UW = 8720;
constexpr int U_GQ = 0, U_GK = 512, U_GV = 1024, U_GR = 2048, U_SQ = 3072, U_SK = 4096, U_SV = 4352, U_GA = 4608, U_GB = 6656, U_GAD = 8704;
constexpr int NIN_PAD = 8960;
constexpr float EPSV = 1e-6f;
constexpr size_t O_YP = 0, O_YS = 16777216, O_PMK = 16842752, O_PMV = 16859136, O_PWK = 16875520, O_PWV = 17006592, O_PGLA = 17137664,
                 O_SWK = 17661952, O_SWV = 18710528, O_SGLA = 19759104;
constexpr size_t WS_BT1IN = 0;
constexpr size_t WS_BT1OUT = WS_BT1IN + (size_t)11264 * 2048 * 2;
constexpr size_t WS_BTIN = WS_BT1OUT + (size_t)2048 * 5632 * 2;
constexpr size_t WS_BTGO = WS_BTIN + (size_t)NIN_PAD * 2048 * 2;
constexpr size_t WS_BTSO = WS_BTGO + (size_t)2048 * 1024 * 2;
constexpr size_t WS_BTOUT = WS_BTSO + (size_t)2048 * 1024 * 2;
constexpr size_t WS_BT2IN = WS_BTOUT + (size_t)2048 * 2048 * 2;
constexpr size_t WS_BT2OUT = WS_BT2IN + (size_t)11264 * 2048 * 2;
constexpr size_t WS_A = WS_BT2OUT + (size_t)2048 * 5632 * 2;
constexpr size_t WS_UH = WS_A + (size_t)RT * 2048 * 2;
constexpr size_t WS_OG = WS_UH + (size_t)RT * UW * 2;
constexpr size_t WS_O = WS_OG + (size_t)RT * 1024 * 2;
constexpr size_t WS_PART = WS_O + (size_t)RT * 1024 * 2;
constexpr size_t WS_HX = WS_PART + (size_t)RT * 32 * 4;
constexpr size_t WS_PARTX = WS_HX + (size_t)256 * 2048 * 4;
constexpr size_t WS_QT = WS_PARTX + (size_t)64 * 128 * 4;
constexpr size_t WS_KH = WS_QT + (size_t)512 * 8192 * 2;
constexpr size_t WS_ATT = WS_KH + (size_t)512 * 8192 * 2;
constexpr size_t WS_DEC = WS_ATT + (size_t)512 * 4096 * 2;
constexpr size_t WS_BAR = WS_DEC + (size_t)512 * 128 * 4;
constexpr int CNT_WORDS = 64 * 40;
constexpr size_t WS_CNT = WS_BAR + (size_t)XCD_BAR_WORDS * 4;
constexpr size_t WS_END = WS_CNT + (size_t)CNT_WORDS * 4;
constexpr int LDS_BYTES = 131072 + 16;
constexpr int NPHASE = 12;

struct Params { const float* in[25]; float* out; unsigned char* ws; int ph_lo, ph_hi; };

__device__ __forceinline__ float bf2f(unsigned short b) { return __uint_as_float(((unsigned)b) << 16); }
__device__ __forceinline__ float bflo(unsigned w) { return __uint_as_float(w << 16); }
__device__ __forceinline__ float bfhi(unsigned w) { return __uint_as_float(w & 0xffff0000u); }
__device__ __forceinline__ unsigned short f2bf(float f) { return (unsigned short)(cvt_pk_bf16(f, 0.f) & 0xffffu); }
__device__ __forceinline__ float wave_sum(float v) {
#pragma unroll
    for (int o = 1; o < 64; o <<= 1) v += __shfl_xor(v, o);
    return v;
}
__device__ __forceinline__ float wave_max(float v) {
#pragma unroll
    for (int o = 1; o < 64; o <<= 1) v = fmaxf(v, __shfl_xor(v, o));
    return v;
}
__device__ __forceinline__ float sigmoidf_(float x) { return 1.f / (1.f + __expf(-x)); }
__device__ __forceinline__ float siluf_(float x) { return x / (1.f + __expf(-x)); }
__device__ __forceinline__ float logsigf_(float x) { return fminf(x, 0.f) - log1pf(__expf(-fabsf(x))); }
__device__ __forceinline__ f32x4 mfma16(bf16x8 a, bf16x8 b, f32x4 c) { return __builtin_amdgcn_mfma_f32_16x16x32_bf16(a, b, c, 0, 0, 0); }
__device__ __forceinline__ u32x2 pack4(f32x4 v) { u32x2 r; r.x = cvt_pk_bf16(v[0], v[1]); r.y = cvt_pk_bf16(v[2], v[3]); return r; }
__device__ __forceinline__ u32x2 pack4c(f32x4 v) { u32x2 r; r.x = pg8::cvt_pk_bf16_c(v[0], v[1]); r.y = pg8::cvt_pk_bf16_c(v[2], v[3]); return r; }
__device__ __forceinline__ float rstd_of(const float* part, int row) {
    const f32x4* p = (const f32x4*)(part + (size_t)row * 32);
    f32x4 s = p[0];
#pragma unroll
    for (int i = 1; i < 8; ++i) s += p[i];
    return rsqrtf(((s[0] + s[1]) + (s[2] + s[3])) * (1.f / 2048.f) + EPSV);
}

__device__ __forceinline__ float rstd_x(const float* partx, int row) {
    const int rl = row - NPR; if (rl >= 64) return 1.f;
    const f32x4* p = (const f32x4*)(partx + (size_t)rl * 128);
    f32x4 s = p[0];
#pragma unroll
    for (int i = 1; i < 32; ++i) s += p[i];
    return rsqrtf(((s[0] + s[1]) + (s[2] + s[3])) * (1.f / 2048.f) + EPSV);
}

template <int MODE> struct Epi {
    static constexpr bool PERM = false, AFTER_DRAIN = (MODE == 5);
    template <class LP> __device__ __forceinline__ void fused(const f32x4 (&acc)[2][2][4][2], const pg8::Unit& u, int wr, int wc, int fr, int fq, LP, int, int) const { (*this)(acc, u, wr, wc, fr, fq); }
    bf16_t* outb; float* hmain; const float* hsrc; float* hx; const float* part_in; const float* partx; float* part_out; const float* gvec; const bf16_t* U; const float* gbias; float scale; int uoff, boff; unsigned* cnt; const float* fnorm;
    __device__ __forceinline__ void operator()(const f32x4 (&acc)[2][2][4][2], const pg8::Unit& u, int wr, int wc, int fr, int fq) const {
        const int row0 = u.pm * 256 + wr * 64 + fr;
        if constexpr (MODE == 0) {
            float rsv[8];
#pragma unroll
            for (int i = 0; i < 8; ++i) rsv[i] = part_in[row0 + (i >> 2) * 128 + (i & 3) * 16];
#pragma unroll
            for (int i = 0; i < 8; ++i) rsv[i] = rsqrtf(rsv[i] * (1.f / 2048.f) + EPSV);
            const int j0 = u.pn * 128 + wc * 16 + 4 * fq;
#pragma unroll
            for (int ai = 0; ai < 2; ++ai)
#pragma unroll
                for (int m = 0; m < 4; ++m) {
                    const int row = row0 + ai * 128 + m * 16; const float rs = rsv[ai * 4 + m];
#pragma unroll
                    for (int bj = 0; bj < 2; ++bj) {
                        f32x4 a = acc[ai][bj][m][0] * rs, b = acc[ai][bj][m][1] * rs, hv;
#pragma unroll
                        for (int j = 0; j < 4; ++j) hv[j] = siluf_(a[j]) * b[j];
                        *(u32x2*)(outb + (size_t)row * FF + j0 + bj * 64) = pack4(hv);
                    }
                }
        } else if constexpr (MODE == 1) {
            float* hb = hmain; const float* hs = hsrc;
            const int col0 = u.pn * 256 + wc * 32 + 4 * fq;
            f32x4 gv[4];
#pragma unroll
            for (int q = 0; q < 4; ++q) gv[q] = gvec ? *(const f32x4*)(gvec + col0 + (q >> 1) * 128 + (q & 1) * 16) : (f32x4){0.f, 0.f, 0.f, 0.f};
            f32x4 hn[4];
#pragma unroll
            for (int q = 0; q < 4; ++q) hn[q] = *(const f32x4*)(hs + (size_t)row0 * DM + col0 + (q >> 1) * 128 + (q & 1) * 16);
#pragma unroll
            for (int i = 0; i < 8; ++i) {
                const int ai = i >> 2, m = i & 3, row = row0 + ai * 128 + m * 16; float ss = 0.f;
                f32x4 hc[4];
#pragma unroll
                for (int q = 0; q < 4; ++q) hc[q] = hn[q];
                if (i < 7) {
                    const int rown = row0 + ((i + 1) >> 2) * 128 + ((i + 1) & 3) * 16;
#pragma unroll
                    for (int q = 0; q < 4; ++q) hn[q] = *(const f32x4*)(hs + (size_t)rown * DM + col0 + (q >> 1) * 128 + (q & 1) * 16);
                }
#pragma unroll
                for (int q = 0; q < 4; ++q) {
                    const int bj = q >> 1, n = q & 1, col = col0 + bj * 128 + n * 16;
                    const f32x4 hv = hc[q] + acc[ai][bj][m][n] * scale;
                    *(f32x4*)(hb + (size_t)row * DM + col) = hv;
                    if (gvec) {
                        ss += (hv[0] * hv[0] + hv[1] * hv[1]) + (hv[2] * hv[2] + hv[3] * hv[3]);
                        *(u32x2*)(outb + (size_t)row * DM + col) = pack4(hv * gv[q]);
                    }
                }
                if (gvec) {
                    ss += __shfl_xor(ss, 16); ss += __shfl_xor(ss, 32);
                    if (fq == 0) unsafeAtomicAdd(part_out + row, ss);
                }
            }
        } else if constexpr (MODE == 5) {
            f32x4 (&hv)[2][2][4][2] = const_cast<f32x4 (&)[2][2][4][2]>(acc);
            float* hb = hmain; const float* hs = hsrc;
            const int col0 = u.pn * 256 + wc * 32 + 4 * fq;
            f32x4 hn[4];
#pragma unroll
            for (int q = 0; q < 4; ++q) hn[q] = *(const f32x4*)(hs + (size_t)row0 * DM + col0 + (q >> 1) * 128 + (q & 1) * 16);
#pragma unroll
            for (int i = 0; i < 8; ++i) {
                const int ai = i >> 2, m = i & 3, row = row0 + ai * 128 + m * 16; float ss = 0.f;
                f32x4 hc[4];
#pragma unroll
                for (int q = 0; q < 4; ++q) hc[q] = hn[q];
                if (i < 7) {
                    const int rown = row0 + ((i + 1) >> 2) * 128 + ((i + 1) & 3) * 16;
#pragma unroll
                    for (int q = 0; q < 4; ++q) hn[q] = *(const f32x4*)(hs + (size_t)rown * DM + col0 + (q >> 1) * 128 + (q & 1) * 16);
                }
#pragma unroll
                for (int q = 0; q < 4; ++q) {
                    const int bj = q >> 1, n = q & 1;
                    const f32x4 v = hc[q] + acc[ai][bj][m][n] * scale;
                    hv[ai][bj][m][n] = v;
                    ss += (v[0] * v[0] + v[1] * v[1]) + (v[2] * v[2] + v[3] * v[3]);
                }
                ss += __shfl_xor(ss, 16); ss += __shfl_xor(ss, 32);
                if (fq == 0) unsafeAtomicAdd(part_out + row, ss);
            }
            asm volatile("s_waitcnt vmcnt(0)" ::: "memory");
            unsigned* cw = cnt + 64 * u.pm;
            if (fr == 0 && fq == 0) (void)__hip_atomic_fetch_add(cw, 1u, __ATOMIC_RELAXED, __HIP_MEMORY_SCOPE_AGENT);
            { unsigned sp = 0; while ((unsigned)__builtin_amdgcn_readfirstlane(__hip_atomic_load(cw, __ATOMIC_RELAXED, __HIP_MEMORY_SCOPE_AGENT)) < 64u) { __builtin_amdgcn_s_sleep(2); if (++sp > (1u << 20)) break; } }
            f32x4 fv[4];
#pragma unroll
            for (int q = 0; q < 4; ++q) fv[q] = *(const f32x4*)(fnorm + col0 + (q >> 1) * 128 + (q & 1) * 16);
            float rsv[8];
#pragma unroll
            for (int i = 0; i < 8; ++i) rsv[i] = __hip_atomic_load(part_out + row0 + (i >> 2) * 128 + (i & 3) * 16, __ATOMIC_RELAXED, __HIP_MEMORY_SCOPE_AGENT);
#pragma unroll
            for (int i = 0; i < 8; ++i) rsv[i] = rsqrtf(rsv[i] * (1.f / 2048.f) + EPSV);
#pragma unroll
            for (int i = 0; i < 8; ++i) {
                const int ai = i >> 2, m = i & 3, row = row0 + ai * 128 + m * 16;
#pragma unroll
                for (int q = 0; q < 4; ++q) { const int bj = q >> 1, n = q & 1; *(f32x4*)(hb + (size_t)row * DM + col0 + bj * 128 + n * 16) = hv[ai][bj][m][n] * rsv[i] * fv[q]; }
            }
        } else if constexpr (MODE == 2) {
            float rsv[8];
#pragma unroll
            for (int i = 0; i < 8; ++i) rsv[i] = part_in[row0 + (i >> 2) * 128 + (i & 3) * 16];
#pragma unroll
            for (int i = 0; i < 8; ++i) rsv[i] = rsqrtf(rsv[i] * (1.f / 2048.f) + EPSV);
            const int col0 = u.pn * 256 + wc * 32 + 4 * fq;
#pragma unroll
            for (int ai = 0; ai < 2; ++ai)
#pragma unroll
                for (int m = 0; m < 4; ++m) {
                    const int row = row0 + ai * 128 + m * 16; const float rs = rsv[ai * 4 + m];
#pragma unroll
                    for (int bj = 0; bj < 2; ++bj)
#pragma unroll
                        for (int n = 0; n < 2; ++n) {
                            const int col = col0 + bj * 128 + n * 16;
                            if (col < UW) *(u32x2*)(outb + (size_t)row * UW + col) = pack4(acc[ai][bj][m][n] * rs);
                        }
                }
        } else {
            const int col0 = u.pn * 256 + wc * 32 + 4 * fq;
            f32x4 gbv[4];
#pragma unroll
            for (int q = 0; q < 4; ++q) gbv[q] = *(const f32x4*)(gbias + boff + col0 + (q >> 1) * 128 + (q & 1) * 16);
            u32x2 gn[4], on[4];
#pragma unroll
            for (int q = 0; q < 4; ++q) {
                gn[q] = *(const u32x2*)(U + (size_t)row0 * UW + uoff + col0 + (q >> 1) * 128 + (q & 1) * 16);
                if constexpr (MODE == 4) on[q] = *(const u32x2*)(outb + (size_t)row0 * DM + col0 + (q >> 1) * 128 + (q & 1) * 16);
            }
#pragma unroll
            for (int i = 0; i < 8; ++i) {
                const int ai = i >> 2, m = i & 3, row = row0 + ai * 128 + m * 16;
                u32x2 gc[4], oc[4];
#pragma unroll
                for (int q = 0; q < 4; ++q) { gc[q] = gn[q]; if constexpr (MODE == 4) oc[q] = on[q]; }
                if (i < 7) {
                    const int rown = row0 + ((i + 1) >> 2) * 128 + ((i + 1) & 3) * 16;
#pragma unroll
                    for (int q = 0; q < 4; ++q) {
                        gn[q] = *(const u32x2*)(U + (size_t)rown * UW + uoff + col0 + (q >> 1) * 128 + (q & 1) * 16);
                        if constexpr (MODE == 4) on[q] = *(const u32x2*)(outb + (size_t)rown * DM + col0 + (q >> 1) * 128 + (q & 1) * 16);
                    }
                }
#pragma unroll
                for (int q = 0; q < 4; ++q) {
                    const int bj = q >> 1, n = q & 1, col = col0 + bj * 128 + n * 16;
                    const u32x2 gw = gc[q]; const f32x4 gb = gbv[q];
                    f32x4 v; const f32x4 a = acc[ai][bj][m][n];
                    v[0] = sigmoidf_(bflo(gw.x) + gb[0]) * a[0]; v[1] = sigmoidf_(bfhi(gw.x) + gb[1]) * a[1];
                    v[2] = sigmoidf_(bflo(gw.y) + gb[2]) * a[2]; v[3] = sigmoidf_(bfhi(gw.y) + gb[3]) * a[3];
                    if constexpr (MODE == 4) { const u32x2 o = oc[q]; v[0] += bflo(o.x); v[1] += bfhi(o.x); v[2] += bflo(o.y); v[3] += bfhi(o.y); }
                    *(u32x2*)(outb + (size_t)row * DM + col) = pack4(v);
                }
            }
        }
    }
};

template <int MODE> __device__ __forceinline__ void run_gemm(PG8_LAS unsigned char* lds, const bf16_t* A, const bf16_t* Bt, int M, int N, int K, const Epi<MODE>& E) {
    pg8::Gemm g; g.A = A; g.Bt = Bt; g.M = M; g.N = N; g.K = K;
    pg8::StaticOrder S; S.init(M, N, (int)gridDim.x, (int)blockIdx.x);
    pg8::gemm_phase<Epi<MODE>, pg8::StaticOrder, false>(lds, g, S, E, nullptr);
}


__device__ __forceinline__ void skinny_acc(const bf16_t* A, int lda, const bf16_t* Bt, int K, int n0, int w, int fr, int fq, f32x4 (&acc)[4]) {
    const int ks = K >> 3, kbeg = w * ks;
    const bf16_t* bp = Bt + (size_t)(n0 + fr) * K + kbeg + 8 * fq;
    const bf16_t* ap = A + (size_t)fr * lda + kbeg + 8 * fq;
#pragma unroll 4
    for (int k0 = 0; k0 < ks; k0 += 32) {
        const bf16x8 bv = *(const bf16x8*)(bp + k0);
#pragma unroll
        for (int mt = 0; mt < 4; ++mt) { const bf16x8 av = *(const bf16x8*)(ap + (size_t)(16 * mt) * lda + k0); acc[mt] = mfma16(bv, av, acc[mt]); }
    }
}
template <int MODE> __device__ __forceinline__ void skinny_phase(unsigned char* smem, const bf16_t* A1, int lda1, const bf16_t* B1, int K, const bf16_t* A2, const bf16_t* B2,
                                                             bf16_t* outb, float* hx, float* partx, const float* gvec, float scale, const bf16_t* U, const float* gbias, unsigned* cnt = nullptr, const float* fnorm = nullptr, float* ys = nullptr) {
    const int tid = threadIdx.x, lane = tid & 63, w = tid >> 6, fr = lane & 15, fq = lane >> 4;
    f32x4* red = (f32x4*)smem;
    for (int c = blockIdx.x; c < 128; c += gridDim.x) {
        const int n0 = 16 * c;
        f32x4 acc[4] = {(f32x4){0.f, 0.f, 0.f, 0.f}, (f32x4){0.f, 0.f, 0.f, 0.f}, (f32x4){0.f, 0.f, 0.f, 0.f}, (f32x4){0.f, 0.f, 0.f, 0.f}};
        skinny_acc(A1, lda1, B1, K, n0, w, fr, fq, acc);
        __syncthreads();
#pragma unroll
        for (int mt = 0; mt < 4; ++mt) red[(w * 4 + mt) * 64 + lane] = acc[mt];
        if constexpr (MODE == 34) {
            f32x4 acc2[4] = {(f32x4){0.f, 0.f, 0.f, 0.f}, (f32x4){0.f, 0.f, 0.f, 0.f}, (f32x4){0.f, 0.f, 0.f, 0.f}, (f32x4){0.f, 0.f, 0.f, 0.f}};
            skinny_acc(A2, lda1, B2, K, n0, w, fr, fq, acc2);
#pragma unroll
            for (int mt = 0; mt < 4; ++mt) red[((8 + w) * 4 + mt) * 64 + lane] = acc2[mt];
        }
        __syncthreads();
        if (tid < 256) {
            const int mt = w, rl = 16 * mt + fr, row = NPR + rl, col = n0 + 4 * fq;
            f32x4 v = red[mt * 64 + lane];
#pragma unroll
            for (int ww = 1; ww < 8; ++ww) v += red[(ww * 4 + mt) * 64 + lane];
            if constexpr (MODE == 1 || MODE == 15) {
                float* hp = hx + (size_t)rl * DM + col;
                const f32x4 hv = *(const f32x4*)hp + v * scale;
                *(f32x4*)hp = hv;
                if (gvec) {
                    const f32x4 g = *(const f32x4*)(gvec + col);
                    float ss = (hv[0] * hv[0] + hv[1] * hv[1]) + (hv[2] * hv[2] + hv[3] * hv[3]);
                    *(u32x2*)(outb + (size_t)row * DM + col) = pack4(hv * g);
                    ss += __shfl_xor(ss, 16); ss += __shfl_xor(ss, 32);
                    if (fq == 0) unsafeAtomicAdd(partx + row, ss);
                }
                if constexpr (MODE == 15) {
                    float ss = (hv[0] * hv[0] + hv[1] * hv[1]) + (hv[2] * hv[2] + hv[3] * hv[3]);
                    ss += __shfl_xor(ss, 16); ss += __shfl_xor(ss, 32);
                    if (fq == 0) unsafeAtomicAdd(partx + row, ss);
                }
            } else {
                f32x4 v2 = red[(8 * 4 + mt) * 64 + lane];
#pragma unroll
                for (int ww = 1; ww < 8; ++ww) v2 += red[((8 + ww) * 4 + mt) * 64 + lane];
                const u32x2 ga = *(const u32x2*)(U + (size_t)row * UW + U_GA + col), gb = *(const u32x2*)(U + (size_t)row * UW + U_GB + col);
                const f32x4 ba = *(const f32x4*)(gbias + col), bb = *(const f32x4*)(gbias + DM + col);
                f32x4 m;
                m[0] = sigmoidf_(bflo(ga.x) + ba[0]) * v[0] + sigmoidf_(bflo(gb.x) + bb[0]) * v2[0];
                m[1] = sigmoidf_(bfhi(ga.x) + ba[1]) * v[1] + sigmoidf_(bfhi(gb.x) + bb[1]) * v2[1];
                m[2] = sigmoidf_(bflo(ga.y) + ba[2]) * v[2] + sigmoidf_(bflo(gb.y) + bb[2]) * v2[2];
                m[3] = sigmoidf_(bfhi(ga.y) + ba[3]) * v[3] + sigmoidf_(bfhi(gb.y) + bb[3]) * v2[3];
                *(u32x2*)(outb + (size_t)row * DM + col) = pack4(m);
            }
        }
    }
    if constexpr (MODE == 15) {
        const int nblk = gridDim.x < 128 ? (int)gridDim.x : 128;
        if ((int)blockIdx.x < nblk) {
            asm volatile("s_waitcnt vmcnt(0)" ::: "memory");
            __syncthreads();
            volatile unsigned& last_flag = *(volatile unsigned*)(smem + 131072 + 8);
            if (tid == 0) {
                __builtin_amdgcn_fence(__ATOMIC_RELEASE, "agent");
                asm volatile("s_waitcnt vmcnt(0)" ::: "memory");
                const unsigned old = __hip_atomic_fetch_add(cnt, 1u, __ATOMIC_RELAXED, __HIP_MEMORY_SCOPE_AGENT);
                last_flag = (old + 1u == (unsigned)nblk) ? 1u : 0u;
                if (last_flag) { __builtin_amdgcn_fence(__ATOMIC_ACQUIRE, "agent"); asm volatile("s_waitcnt vmcnt(0)" ::: "memory"); }
            }
            __syncthreads();
            if (last_flag) {
                for (int r = w; r < 32; r += 8) {
                    const float* src = hx + (size_t)(R_SAMP - NPR + r) * DM; float* dst = ys + (size_t)r * DM;
                    const float ssq = __hip_atomic_load(partx + R_SAMP + r, __ATOMIC_RELAXED, __HIP_MEMORY_SCOPE_AGENT);
                    const float rs = rsqrtf(ssq * (1.f / 2048.f) + EPSV);
#pragma unroll
                    for (int j = 0; j < 8; ++j) {
                        f32x4 v;
                        v[0] = __hip_atomic_load(src + 4 * (lane + 64 * j) + 0, __ATOMIC_RELAXED, __HIP_MEMORY_SCOPE_AGENT); v[1] = __hip_atomic_load(src + 4 * (lane + 64 * j) + 1, __ATOMIC_RELAXED, __HIP_MEMORY_SCOPE_AGENT);
                        v[2] = __hip_atomic_load(src + 4 * (lane + 64 * j) + 2, __ATOMIC_RELAXED, __HIP_MEMORY_SCOPE_AGENT); v[3] = __hip_atomic_load(src + 4 * (lane + 64 * j) + 3, __ATOMIC_RELAXED, __HIP_MEMORY_SCOPE_AGENT);
                        ((f32x4*)dst)[lane + 64 * j] = v * rs * ((const f32x4*)fnorm)[lane + 64 * j];
                    }
                }
            }
        }
    }
    __syncthreads();
}

__device__ __forceinline__ int srccol_rt(int kind, int np) {
    if (kind == 0) return np;
    if (kind == 1) { const int g = np >> 5, n = (np >> 4) & 1, i = np & 15; return n * FF + 16 * g + i; }
    if (np < 3072) return np; if (np < 8704) return np + 16; if (np < 8720) return 3072 + (np - 8704); return -1;
}
struct TrDesc { const float* W; bf16_t* WT; int K, N, nnb, kind, idx; };
constexpr int IT_PRE_END = 2528, IT_1OUT_END = 3232, IT_MIX_END = 3744, IT_2IN_SPLIT = 4096, IT_2IN_END = 5152, IT_END = 5856;
__device__ __forceinline__ bool tr_decode(const Params& p, int it, int hi, TrDesc& d) {
    if (it >= hi) return false;
    unsigned char* ws = p.ws; int r = it;
    if (r < 1408) { d = TrDesc{p.in[9], (bf16_t*)(ws + WS_BT1IN), 2048, 11264, 44, 1, r}; return true; } r -= 1408;
    if (r < 1120) { d = TrDesc{p.in[12], (bf16_t*)(ws + WS_BTIN), 2048, 8720, 35, 2, r}; return true; } r -= 1120;
    if (r < 704) { d = TrDesc{p.in[10], (bf16_t*)(ws + WS_BT1OUT), 5632, 2048, 8, 0, r}; return true; } r -= 704;
    if (r < 128) { d = TrDesc{p.in[16], (bf16_t*)(ws + WS_BTGO), 1024, 2048, 8, 0, r}; return true; } r -= 128;
    if (r < 128) { d = TrDesc{p.in[18], (bf16_t*)(ws + WS_BTSO), 1024, 2048, 8, 0, r}; return true; } r -= 128;
    if (r < 256) { d = TrDesc{p.in[20], (bf16_t*)(ws + WS_BTOUT), 2048, 2048, 8, 0, r}; return true; } r -= 256;
    if (r < 1408) { d = TrDesc{p.in[22], (bf16_t*)(ws + WS_BT2IN), 2048, 11264, 44, 1, r}; return true; } r -= 1408;
    if (r < 704) { d = TrDesc{p.in[23], (bf16_t*)(ws + WS_BT2OUT), 5632, 2048, 8, 0, r}; return true; }
    return false;
}
__device__ __forceinline__ void tr_load(const TrDesc& d, int tid, f32x4 (&v)[8]) {
    const int kb = d.idx / d.nnb, nb = d.idx - kb * d.nnb, col4 = tid & 63, krow = tid >> 6;
    const int c = srccol_rt(d.kind, nb * 256 + 4 * col4);
    const float* src = d.W + (size_t)(kb * 64 + krow) * d.N + (c >= 0 ? c : 0);
#pragma unroll
    for (int i = 0; i < 8; ++i) v[i] = (c >= 0) ? *(const f32x4*)(src + (size_t)(8 * i) * d.N) : (f32x4){0.f, 0.f, 0.f, 0.f};
}
__device__ __forceinline__ void convert_items(const Params& p, unsigned char* smem, int lo, int hi, int first, int stride) {
    const int tid = threadIdx.x;
    float* tile = (float*)smem;
    int it = lo + first; TrDesc d; bool has = tr_decode(p, it, hi, d); f32x4 v[8];
    if (has) tr_load(d, tid, v);
    const int col4 = tid & 63, krow = tid >> 6, c8 = tid & 7;
    __syncthreads();
    while (has) {
#pragma unroll
        for (int i = 0; i < 8; ++i) { const int kk = krow + 8 * i; *(f32x4*)(tile + kk * 256 + 4 * (col4 ^ ((kk >> 3) & 7))) = v[i]; }
        TrDesc dn; const bool hn = tr_decode(p, it + stride, hi, dn);
        __syncthreads();
        if (hn) tr_load(dn, tid, v);
        const int kb = d.idx / d.nnb, nb = d.idx - kb * d.nnb;
#pragma unroll
        for (int j = 0; j < 4; ++j) {
            const int n = (tid >> 3) + 64 * j; const float* s = tile + (8 * c8) * 256 + 4 * ((n >> 2) ^ c8) + (n & 3);
            u32x4 o; o.x = cvt_pk_bf16(s[0 * 256], s[1 * 256]); o.y = cvt_pk_bf16(s[2 * 256], s[3 * 256]); o.z = cvt_pk_bf16(s[4 * 256], s[5 * 256]); o.w = cvt_pk_bf16(s[6 * 256], s[7 * 256]);
            *(u32x4*)(d.WT + (size_t)(nb * 256 + n) * d.K + kb * 64 + 8 * c8) = o;
        }
        __syncthreads();
        d = dn; has = hn; it += stride;
    }
}
__device__ __forceinline__ void convert_in_tail(const Params& p, unsigned char* smem, int nunits, int lo, int hi) {
    const int G = gridDim.x, extra = nunits % G, bid = blockIdx.x;
    if (extra == 0) convert_items(p, smem, lo, hi, bid, G);
    else if (bid >= extra) convert_items(p, smem, lo, hi, bid - extra, G - extra);
}
__device__ __forceinline__ void phase_pre(const Params& p, unsigned char* smem) {
    const int tid = threadIdx.x, lane = tid & 63, wave = tid >> 6, G = gridDim.x;
    convert_items(p, smem, 0, IT_PRE_END, blockIdx.x, G);
    const int gw = blockIdx.x * 8 + wave, NGW = G * 8;
    unsigned char* ws = p.ws;
    const float* g1 = p.in[8];
    bf16_t* A = (bf16_t*)(ws + WS_A); float* part = (float*)(ws + WS_PART); float* hx = (float*)(ws + WS_HX);
    for (int r = gw; r < RT; r += NGW) {
        const float* src = r < NPR ? p.in[0] + (size_t)r * DM : r < R_SAMP ? p.in[7] + (size_t)(r - R_META) * DM : r < R_SAMP + 32 ? p.in[1] + (size_t)(r - R_SAMP) * DM : nullptr;
        f32x4 v[8]; float s = 0.f;
#pragma unroll
        for (int j = 0; j < 8; ++j) { v[j] = src ? ((const f32x4*)src)[lane + 64 * j] : (f32x4){0.f, 0.f, 0.f, 0.f}; s += (v[j][0] * v[j][0] + v[j][1] * v[j][1]) + (v[j][2] * v[j][2] + v[j][3] * v[j][3]); }
        const float tot = wave_sum(s);
#pragma unroll
        for (int j = 0; j < 8; ++j) { if (r >= NPR) ((f32x4*)(hx + (size_t)(r - NPR) * DM))[lane + 64 * j] = v[j]; const f32x4 g = ((const f32x4*)g1)[lane + 64 * j];
            *(u32x2*)(A + (size_t)r * DM + 4 * (lane + 64 * j)) = pack4(v[j] * g); }
        if (lane < 4) part[(size_t)lane * RT + r] = (lane == 0) ? tot : 0.f;
    }
}

__device__ __forceinline__ void gla_prep_item(const Params& p, unsigned char* smem, int item) {
    const int tid = threadIdx.x, lane = tid & 63, w = tid >> 6, fr = lane & 15, fq = lane >> 4;
    const int b = item >> 7, h = (item >> 5) & 3, c = item & 31, row0 = b * 2048 + 64 * c;
    float* Bc = (float*)smem;
    bf16_t* Qt = (bf16_t*)(smem + 32768);
    bf16_t* Kt = Qt + 64 * 136;
    float* GAD = (float*)(Kt + 64 * 136);
    float* TOT = GAD + 64 * 16;
    const bf16_t* U = (const bf16_t*)(p.ws + WS_UH);
    bf16_t* QTw = (bf16_t*)(p.ws + WS_QT) + (size_t)item * 8192;
    bf16_t* KHw = (bf16_t*)(p.ws + WS_KH) + (size_t)item * 8192;
    bf16_t* ATw = (bf16_t*)(p.ws + WS_ATT) + (size_t)item * 4096;
    float* DECw = (float*)(p.ws + WS_DEC) + (size_t)item * 128;
    const int d1 = tid & 127, tg = tid >> 7, t8 = tid >> 3, p8 = tid & 7;
    float aup[16];
#pragma unroll
    for (int r = 0; r < 16; ++r) aup[r] = p.in[13][r * 512 + h * 128 + d1];
    const float bias1 = p.in[14][h * 128 + d1];
    __syncthreads();
    {
        const unsigned gw = *(const unsigned*)(U + (size_t)(row0 + t8) * UW + U_GAD + 2 * p8);
        GAD[t8 * 16 + 2 * p8] = bflo(gw); GAD[t8 * 16 + 2 * p8 + 1] = bfhi(gw);
    }
    float kc[16];
#pragma unroll
    for (int i = 0; i < 16; ++i) kc[i] = bf2f(U[(size_t)(row0 + tg * 16 + i) * UW + U_GK + h * 128 + d1]);
    __syncthreads();
    float bl[16]; float run = 0.f;
#pragma unroll
    for (int i = 0; i < 16; ++i) { const int t = tg * 16 + i; float x = bias1;
#pragma unroll
        for (int r = 0; r < 16; ++r) x += GAD[t * 16 + r] * aup[r];
        run += logsigf_(x) * (1.f / 16.f); bl[i] = run; }
    TOT[tg * 128 + d1] = run;
    __syncthreads();
    {
        float pre = 0.f, blast = 0.f;
#pragma unroll
        for (int g = 0; g < 4; ++g) { const float tv = TOT[g * 128 + d1]; blast += tv; if (g < tg) pre += tv; }
        float kh[16];
#pragma unroll
        for (int i = 0; i < 16; ++i) { bl[i] += pre; Bc[(tg * 16 + i) * 128 + d1] = bl[i]; kh[i] = kc[i] * __expf(blast - bl[i]); }
        u32x4 o0, o1;
        o0.x = cvt_pk_bf16(kh[0], kh[1]); o0.y = cvt_pk_bf16(kh[2], kh[3]); o0.z = cvt_pk_bf16(kh[4], kh[5]); o0.w = cvt_pk_bf16(kh[6], kh[7]);
        o1.x = cvt_pk_bf16(kh[8], kh[9]); o1.y = cvt_pk_bf16(kh[10], kh[11]); o1.z = cvt_pk_bf16(kh[12], kh[13]); o1.w = cvt_pk_bf16(kh[14], kh[15]);
        *(u32x4*)(KHw + d1 * 64 + tg * 16) = o0; *(u32x4*)(KHw + d1 * 64 + tg * 16 + 8) = o1;
        if (tg == 0) DECw[d1] = __expf(blast);
    }
    __syncthreads();
    {
        const int d0 = p8 * 16; const bf16_t* ur = U + (size_t)(row0 + t8) * UW + h * 128 + d0;
        const u32x4 q0 = *(const u32x4*)(ur + U_GQ), q1 = *(const u32x4*)(ur + U_GQ + 8), k0 = *(const u32x4*)(ur + U_GK), k1 = *(const u32x4*)(ur + U_GK + 8);
        const unsigned qw[8] = {q0.x, q0.y, q0.z, q0.w, q1.x, q1.y, q1.z, q1.w}, kw[8] = {k0.x, k0.y, k0.z, k0.w, k1.x, k1.y, k1.z, k1.w};
        unsigned qo[8], ko[8];
#pragma unroll
        for (int e = 0; e < 8; ++e) {
            const float b0 = Bc[t8 * 128 + d0 + 2 * e], b1 = Bc[t8 * 128 + d0 + 2 * e + 1];
            qo[e] = cvt_pk_bf16(bflo(qw[e]) * 0.08838834764831845f * __expf(b0), bfhi(qw[e]) * 0.08838834764831845f * __expf(b1));
            ko[e] = cvt_pk_bf16(bflo(kw[e]) * __expf(-b0), bfhi(kw[e]) * __expf(-b1));
        }
        const u32x4 qa = {qo[0], qo[1], qo[2], qo[3]}, qb = {qo[4], qo[5], qo[6], qo[7]};
        *(u32x4*)(Qt + t8 * 136 + d0) = qa; *(u32x4*)(Qt + t8 * 136 + d0 + 8) = qb;
        *(u32x4*)(QTw + t8 * 128 + d0) = qa; *(u32x4*)(QTw + t8 * 128 + d0 + 8) = qb;
        *(u32x4*)(Kt + t8 * 136 + d0) = (u32x4){ko[0], ko[1], ko[2], ko[3]}; *(u32x4*)(Kt + t8 * 136 + d0 + 8) = (u32x4){ko[4], ko[5], ko[6], ko[7]};
    }
    __syncthreads();
    {
        const int tt = w >> 1;
#pragma unroll
        for (int si = 0; si < 2; ++si) {
            const int st = 2 * (w & 1) + si; f32x4 acc = {0.f, 0.f, 0.f, 0.f};
            if (st <= tt) {
#pragma unroll
                for (int kk = 0; kk < 4; ++kk) {
                    const bf16x8 a = *(const bf16x8*)(Kt + (16 * st + fr) * 136 + 8 * fq + 32 * kk);
                    const bf16x8 bq = *(const bf16x8*)(Qt + (16 * tt + fr) * 136 + 8 * fq + 32 * kk);
                    acc = mfma16(a, bq, acc);
                }
                if (st == tt) {
#pragma unroll
                    for (int r = 0; r < 4; ++r) if (4 * fq + r > fr) acc[r] = 0.f;
                }
            }
            *(u32x2*)(ATw + (16 * tt + fr) * 64 + 16 * st + 4 * fq) = pack4c(acc);
        }
    }
}

__device__ __forceinline__ void gla_scan_unit(const Params& p, unsigned char* smem, int unit) {
    const int tid = threadIdx.x, lane = tid & 63, w = tid >> 6, fr = lane & 15, fq = lane >> 4;
    const int b = unit >> 5, h = (unit >> 3) & 3, dvs = unit & 7;
    float* Bc = (float*)smem;
    bf16_t* KhT = (bf16_t*)(smem + 32768);
    bf16_t* VT = KhT + 128 * 72;
    bf16_t* ST = VT + 2 * 32 * 72;
    float* GAD = (float*)(ST + 2 * 32 * 136);
    float* TOT = GAD + 64 * 16;
    const bf16_t* U = (const bf16_t*)(p.ws + WS_UH);
    bf16_t* Og = (bf16_t*)(p.ws + WS_OG);
    const int d1 = tid & 127, tg = tid >> 7, t8 = tid >> 3, p8 = tid & 7;
    f32x4 Sacc[2] = {(f32x4){0.f, 0.f, 0.f, 0.f}, (f32x4){0.f, 0.f, 0.f, 0.f}};
    const int vcol = U_GV + h * 256 + dvs * 32 + 4 * p8;
    {
        const size_t it0 = (size_t)((b * 4 + h) * 32);
        const char* tq = (const char*)((const bf16_t*)(p.ws + WS_QT) + it0 * 8192) + (size_t)dvs * 65536;
        const char* tk = (const char*)((const bf16_t*)(p.ws + WS_KH) + it0 * 8192) + (size_t)dvs * 65536;
        const char* ta = (const char*)((const bf16_t*)(p.ws + WS_ATT) + it0 * 4096) + (size_t)dvs * 32768;
        unsigned acc_t = *(const unsigned*)(tq + (size_t)tid * 128) | *(const unsigned*)(tk + (size_t)tid * 128);
        if (tid < 256) acc_t |= *(const unsigned*)(ta + (size_t)tid * 128);
#pragma unroll
        for (int k = 0; k < 4; ++k) acc_t |= *(const unsigned*)(U + (size_t)(b * 2048 + tid + 512 * k) * UW + U_GV + h * 256 + dvs * 32);
        asm volatile("" :: "v"(acc_t));
    }
    __syncthreads();
    {
        float aup[16];
#pragma unroll
        for (int r = 0; r < 16; ++r) aup[r] = p.in[13][r * 512 + h * 128 + d1];
        const float bias1 = p.in[14][h * 128 + d1];
        {
            const bool ok = t8 < 16; const bf16_t* ur = U + (size_t)(R_META + (ok ? t8 : 0)) * UW;
            const unsigned gw = ok ? *(const unsigned*)(ur + U_GAD + 2 * p8) : 0u;
            GAD[t8 * 16 + 2 * p8] = bflo(gw); GAD[t8 * 16 + 2 * p8 + 1] = bfhi(gw);
            const u32x2 vw = ok ? *(const u32x2*)(ur + vcol) : (u32x2){0u, 0u};
            VT[(4 * p8 + 0) * 72 + t8] = (bf16_t)(vw.x & 0xffffu); VT[(4 * p8 + 1) * 72 + t8] = (bf16_t)(vw.x >> 16);
            VT[(4 * p8 + 2) * 72 + t8] = (bf16_t)(vw.y & 0xffffu); VT[(4 * p8 + 3) * 72 + t8] = (bf16_t)(vw.y >> 16);
        }
        float kc[16];
#pragma unroll
        for (int i = 0; i < 16; ++i) kc[i] = (tg == 0) ? bf2f(U[(size_t)(R_META + i) * UW + U_GK + h * 128 + d1]) : 0.f;
        __syncthreads();
        float bl[16]; float run = 0.f;
#pragma unroll
        for (int i = 0; i < 16; ++i) { const int t = tg * 16 + i; float x = bias1;
#pragma unroll
            for (int r = 0; r < 16; ++r) x += GAD[t * 16 + r] * aup[r];
            const float lg = (tg == 0) ? logsigf_(x) * (1.f / 16.f) : 0.f; run += lg; bl[i] = run; }
        TOT[tg * 128 + d1] = run;
        __syncthreads();
        {
            float pre = 0.f, blast = 0.f;
#pragma unroll
            for (int g = 0; g < 4; ++g) { const float tv = TOT[g * 128 + d1]; blast += tv; if (g < tg) pre += tv; }
            float kh[16];
#pragma unroll
            for (int i = 0; i < 16; ++i) { bl[i] += pre; kh[i] = kc[i] * __expf(blast - bl[i]); }
            if (tg == 0) Bc[d1] = blast;
            u32x4 o0, o1;
            o0.x = cvt_pk_bf16(kh[0], kh[1]); o0.y = cvt_pk_bf16(kh[2], kh[3]); o0.z = cvt_pk_bf16(kh[4], kh[5]); o0.w = cvt_pk_bf16(kh[6], kh[7]);
            o1.x = cvt_pk_bf16(kh[8], kh[9]); o1.y = cvt_pk_bf16(kh[10], kh[11]); o1.z = cvt_pk_bf16(kh[12], kh[13]); o1.w = cvt_pk_bf16(kh[14], kh[15]);
            *(u32x4*)(KhT + d1 * 72 + tg * 16) = o0; *(u32x4*)(KhT + d1 * 72 + tg * 16 + 8) = o1;
        }
        __syncthreads();
#pragma unroll
        for (int dvt = 0; dvt < 2; ++dvt) {
            f32x4 nw = {0.f, 0.f, 0.f, 0.f};
#pragma unroll
            for (int kk = 0; kk < 2; ++kk) {
                const bf16x8 a = *(const bf16x8*)(KhT + (16 * w + fr) * 72 + 8 * fq + 32 * kk);
                const bf16x8 bb = *(const bf16x8*)(VT + (16 * dvt + fr) * 72 + 8 * fq + 32 * kk);
                nw = mfma16(a, bb, nw);
            }
            Sacc[dvt] = nw;
        }
    }
    const size_t item0 = (size_t)((b * 4 + h) * 32);
    const bf16_t* QTw = (const bf16_t*)(p.ws + WS_QT) + item0 * 8192 + (16 * (w >> 1) + fr) * 128 + 8 * fq;
    const bf16_t* ATw = (const bf16_t*)(p.ws + WS_ATT) + item0 * 4096 + (16 * (w >> 1) + fr) * 64 + 8 * fq;
    const bf16_t* KHw = (const bf16_t*)(p.ws + WS_KH) + item0 * 8192 + (16 * w + fr) * 64 + 8 * fq;
    const float* DECw = (const float*)(p.ws + WS_DEC) + item0 * 128 + 16 * w + 4 * fq;
    const bf16_t* Vg = U + (size_t)(b * 2048 + t8) * UW + vcol;
    struct Ops { bf16x8 q[4], a[2], kh[2]; f32x4 dec; u32x2 v; };
    Ops r0, r1, r2;
#define GLA_LOAD(R, cc) do { const int c_ = (cc) < 32 ? (cc) : 31; \
        _Pragma("unroll") for (int kk = 0; kk < 4; ++kk) R.q[kk] = *(const bf16x8*)(QTw + (size_t)c_ * 8192 + 32 * kk); \
        _Pragma("unroll") for (int kk = 0; kk < 2; ++kk) { R.a[kk] = *(const bf16x8*)(ATw + (size_t)c_ * 4096 + 32 * kk); R.kh[kk] = *(const bf16x8*)(KHw + (size_t)c_ * 8192 + 32 * kk); } \
        R.dec = *(const f32x4*)(DECw + c_ * 128); R.v = *(const u32x2*)(Vg + (size_t)(64 * c_) * UW); } while (0)
    GLA_LOAD(r0, 0); GLA_LOAD(r1, 1);
    __syncthreads();
#pragma unroll
    for (int dvt = 0; dvt < 2; ++dvt) *(u32x2*)(ST + (16 * dvt + fr) * 136 + 16 * w + 4 * fq) = pack4c(Sacc[dvt]);
    VT[(4 * p8 + 0) * 72 + t8] = (bf16_t)(r0.v.x & 0xffffu); VT[(4 * p8 + 1) * 72 + t8] = (bf16_t)(r0.v.x >> 16);
    VT[(4 * p8 + 2) * 72 + t8] = (bf16_t)(r0.v.y & 0xffffu); VT[(4 * p8 + 3) * 72 + t8] = (bf16_t)(r0.v.y >> 16);
#define GLA_BODY(cc, CUR, NX1, FAR) do { const int c = (cc); \
        GLA_LOAD(FAR, c + 2); \
        asm volatile("s_waitcnt lgkmcnt(0)" ::: "memory"); __builtin_amdgcn_s_barrier(); asm volatile("" ::: "memory"); \
        const bf16_t* vt = VT + (c & 1) * (32 * 72); const bf16_t* st = ST + (c & 1) * (32 * 136); \
        { const int tt = w >> 1, dvt = w & 1; f32x4 acc = {0.f, 0.f, 0.f, 0.f}, acc2 = {0.f, 0.f, 0.f, 0.f}; \
          const bf16x8 lv0 = *(const bf16x8*)(vt + (16 * dvt + fr) * 72 + 8 * fq), lv1 = *(const bf16x8*)(vt + (16 * dvt + fr) * 72 + 8 * fq + 32); \
          const bf16x8 ls0 = *(const bf16x8*)(st + (16 * dvt + fr) * 136 + 8 * fq), ls1 = *(const bf16x8*)(st + (16 * dvt + fr) * 136 + 8 * fq + 32), \
                       ls2 = *(const bf16x8*)(st + (16 * dvt + fr) * 136 + 8 * fq + 64), ls3 = *(const bf16x8*)(st + (16 * dvt + fr) * 136 + 8 * fq + 96); \
          __builtin_amdgcn_sched_barrier(0); \
          acc = mfma16(lv0, CUR.a[0], acc); acc2 = mfma16(ls0, CUR.q[0], acc2); acc = mfma16(lv1, CUR.a[1], acc); acc2 = mfma16(ls1, CUR.q[1], acc2); \
          acc = mfma16(ls2, CUR.q[2], acc); acc2 = mfma16(ls3, CUR.q[3], acc2); acc = acc + acc2; \
          *(u32x2*)(Og + (size_t)(b * 2048 + 64 * c + 16 * tt + fr) * 1024 + h * 256 + dvs * 32 + 16 * dvt + 4 * fq) = pack4c(acc); } \
        bf16_t* stn = ST + ((c + 1) & 1) * (32 * 136); bf16_t* vtn = VT + ((c + 1) & 1) * (32 * 72); \
        _Pragma("unroll") for (int dvt = 0; dvt < 2; ++dvt) { f32x4 nw = {0.f, 0.f, 0.f, 0.f}; \
          _Pragma("unroll") for (int kk = 0; kk < 2; ++kk) nw = mfma16(CUR.kh[kk], *(const bf16x8*)(vt + (16 * dvt + fr) * 72 + 8 * fq + 32 * kk), nw); \
          Sacc[dvt] = Sacc[dvt] * CUR.dec + nw; \
          *(u32x2*)(stn + (16 * dvt + fr) * 136 + 16 * w + 4 * fq) = pack4c(Sacc[dvt]); } \
        vtn[(4 * p8 + 0) * 72 + t8] = (bf16_t)(NX1.v.x & 0xffffu); vtn[(4 * p8 + 1) * 72 + t8] = (bf16_t)(NX1.v.x >> 16); \
        vtn[(4 * p8 + 2) * 72 + t8] = (bf16_t)(NX1.v.y & 0xffffu); vtn[(4 * p8 + 3) * 72 + t8] = (bf16_t)(NX1.v.y >> 16); } while (0)
    for (int c3 = 0; c3 < 30; c3 += 3) {
        GLA_BODY(c3, r0, r1, r2);
        GLA_BODY(c3 + 1, r1, r2, r0);
        GLA_BODY(c3 + 2, r2, r0, r1);
    }
    GLA_BODY(30, r0, r1, r2);
    GLA_BODY(31, r1, r2, r0);
#undef GLA_BODY
#undef GLA_LOAD
    float* pg = p.out + O_PGLA + (size_t)((b * 4 + h) * 128) * 256 + dvs * 32;
#pragma unroll
    for (int dvt = 0; dvt < 2; ++dvt)
#pragma unroll
        for (int r = 0; r < 4; ++r) pg[(size_t)(16 * w + 4 * fq + r) * 256 + 16 * dvt + fr] = Sacc[dvt][r];
    __syncthreads();
}

__device__ __forceinline__ void swa_prompt_unit(const Params& p, unsigned char* smem, int unit) {
    const int tid = threadIdx.x, lane = tid & 63, w = tid >> 6, fr = lane & 15, fq = lane >> 4;
    const int b = unit >> 6, kvh = (unit >> 4) & 3, n = unit & 15;
    bf16_t* Ks = (bf16_t*)smem;
    bf16_t* VT = Ks + 272 * 72;
    const bf16_t* U = (const bf16_t*)(p.ws + WS_UH);
    bf16_t* O = (bf16_t*)(p.ws + WS_O);
    __syncthreads();
    {
        u32x4 kv[5], vv[5];
#pragma unroll
        for (int it = 0; it < 5; ++it) {
            const int idx = tid + 512 * it; const int sl = idx >> 3, c8 = idx & 7;
            int row; bool ok = idx < 272 * 8;
            if (sl < 16) row = R_META + sl; else { const int pos = n * 128 + (sl - 16) - 128; ok = ok && pos >= 0; row = b * 2048 + pos; }
            kv[it] = (u32x4){0u, 0u, 0u, 0u}; vv[it] = (u32x4){0u, 0u, 0u, 0u};
            if (ok) { const bf16_t* ur = U + (size_t)row * UW + kvh * 64 + 8 * c8; kv[it] = *(const u32x4*)(ur + U_SK); vv[it] = *(const u32x4*)(ur + U_SV); }
        }
#pragma unroll
        for (int it = 0; it < 5; ++it) {
            const int idx = tid + 512 * it; const int sl = idx >> 3, c8 = idx & 7;
            if (idx < 272 * 8) {
                *(u32x4*)(Ks + sl * 72 + 8 * c8) = kv[it];
                bf16_t* vt = VT + (8 * c8) * 280 + sl; const u32x4 v4 = vv[it];
                vt[0 * 280] = (bf16_t)(v4.x & 0xffffu); vt[1 * 280] = (bf16_t)(v4.x >> 16); vt[2 * 280] = (bf16_t)(v4.y & 0xffffu); vt[3 * 280] = (bf16_t)(v4.y >> 16);
                vt[4 * 280] = (bf16_t)(v4.z & 0xffffu); vt[5 * 280] = (bf16_t)(v4.z >> 16); vt[6 * 280] = (bf16_t)(v4.w & 0xffffu); vt[7 * 280] = (bf16_t)(v4.w >> 16);
            }
        }
    }
    __syncthreads();
    const int qt = w;
    bf16x8 qall[4][2];
#pragma unroll
    for (int g = 0; g < 4; ++g) { const bf16_t* qp0 = U + (size_t)(b * 2048 + n * 128 + 16 * qt + fr) * UW + U_SQ + (kvh * 4 + g) * 64 + 8 * fq; qall[g][0] = *(const bf16x8*)qp0; qall[g][1] = *(const bf16x8*)(qp0 + 32); }
#pragma unroll
    for (int g = 0; g < 4; ++g) {
        const int head = kvh * 4 + g;
        const float slope = exp2f(-0.5f * (float)(head + 1)), sink = p.in[17][head];
        const int qrow = b * 2048 + n * 128 + 16 * qt + fr;
        const bf16x8 qf0 = qall[g][0], qf1 = qall[g][1];
        f32x4 sc[10];
        float mx = -1e30f;
#pragma unroll
        for (int T = 0; T < 10; ++T) {
            const int slot0 = (T == 0) ? 0 : 16 + 16 * (qt + T - 1);
            f32x4 acc = {0.f, 0.f, 0.f, 0.f};
            acc = mfma16(*(const bf16x8*)(Ks + (slot0 + fr) * 72 + 8 * fq), qf0, acc);
            acc = mfma16(*(const bf16x8*)(Ks + (slot0 + fr) * 72 + 8 * fq + 32), qf1, acc);
#pragma unroll
            for (int r = 0; r < 4; ++r) {
                float s = acc[r] * 0.125f;
                if (T > 0) {
                    const int j = 16 * (qt + T - 1) + 4 * fq + r, i = 16 * qt + fr, dist = i + 128 - j;
                    const bool valid = (dist >= 0) && (dist < 128) && (n * 128 + j - 128 >= 0);
                    s = valid ? s - slope * (float)dist : -1e30f;
                }
                acc[r] = s; mx = fmaxf(mx, s);
            }
            sc[T] = acc;
        }
        mx = fmaxf(mx, __shfl_xor(mx, 16)); mx = fmaxf(mx, __shfl_xor(mx, 32)); mx = fmaxf(mx, sink);
        float sum = 0.f;
#pragma unroll
        for (int T = 0; T < 10; ++T)
#pragma unroll
            for (int r = 0; r < 4; ++r) { const float e = __expf(sc[T][r] - mx); sc[T][r] = e; sum += e; }
        sum += __shfl_xor(sum, 16); sum += __shfl_xor(sum, 32);
        const float inv = 1.f / (sum + __expf(sink - mx));
        f32x4 oacc[4] = {(f32x4){0.f, 0.f, 0.f, 0.f}, (f32x4){0.f, 0.f, 0.f, 0.f}, (f32x4){0.f, 0.f, 0.f, 0.f}, (f32x4){0.f, 0.f, 0.f, 0.f}};
#pragma unroll
        for (int pp = 0; pp < 5; ++pp) {
            const int T0 = 2 * pp, T1 = 2 * pp + 1;
            const int s0 = (T0 == 0) ? 0 : 16 + 16 * (qt + T0 - 1), s1 = 16 + 16 * (qt + T1 - 1);
            const u32x2 pa = pack4(sc[T0]), pb = pack4(sc[T1]);
            const u32x4 pw = {pa.x, pa.y, pb.x, pb.y};
            bf16x8 pf; __builtin_memcpy(&pf, &pw, 16);
#pragma unroll
            for (int dvt = 0; dvt < 4; ++dvt) {
                const u32x2 va = *(const u32x2*)(VT + (16 * dvt + fr) * 280 + s0 + 4 * fq), vb = *(const u32x2*)(VT + (16 * dvt + fr) * 280 + s1 + 4 * fq);
                const u32x4 vw = {va.x, va.y, vb.x, vb.y};
                bf16x8 vf; __builtin_memcpy(&vf, &vw, 16);
                oacc[dvt] = mfma16(vf, pf, oacc[dvt]);
            }
        }
#pragma unroll
        for (int dvt = 0; dvt < 4; ++dvt) *(u32x2*)(O + (size_t)qrow * 1024 + head * 64 + 16 * dvt + 4 * fq) = pack4(oacc[dvt] * inv);
    }
    __syncthreads();
}

__device__ __forceinline__ float gla_state_step(const float* __restrict__ s0p, float* __restrict__ snp, const float* eg, const float* kk, const float* qt, float v, int dbeg) {
    float op = 0.f;
#pragma unroll 8
    for (int d = dbeg; d < dbeg + 64; ++d) { const float s0 = s0p[(size_t)d * 256]; snp[(size_t)d * 256] = s0 * eg[d] + kk[d] * v; op += qt[d] * s0; }
    return op;
}
__device__ __forceinline__ void gla_sample_unit(const Params& p, unsigned char* smem, int unit) {
    const int tid = threadIdx.x; const int i = unit >> 2, h = unit & 3, row = R_SAMP + i;
    float* eg = (float*)smem; float* qt = eg + 128; float* kk = qt + 128; float* vv = kk + 128; float* red = vv + 256; float* red2 = red + 128;
    const bf16_t* ur = (const bf16_t*)(p.ws + WS_UH) + (size_t)row * UW;
    bf16_t* Og = (bf16_t*)(p.ws + WS_OG);
    __syncthreads();
    if (tid < 128) {
        const int d = tid; float x = p.in[14][h * 128 + d];
#pragma unroll
        for (int r = 0; r < 16; ++r) x += bf2f(ur[U_GAD + r]) * p.in[13][r * 512 + h * 128 + d];
        const float lg = logsigf_(x) * (1.f / 16.f), e = __expf(lg);
        const float q = bf2f(ur[U_GQ + h * 128 + d]) * 0.08838834764831845f, k = bf2f(ur[U_GK + h * 128 + d]);
        eg[d] = e; qt[d] = q * e; kk[d] = k; red[d] = q * k;
    } else if (tid < 384) { const int dv = tid - 128; vv[dv] = bf2f(ur[U_GV + h * 256 + dv]); }
    __syncthreads();
    float qk = 0.f;
    for (int d = 0; d < 128; ++d) qk += red[d];
    const int dv = tid & 255, half = tid >> 8;
    const float* s0p = p.in[6] + (size_t)((i * 4 + h) * 128) * 256 + dv;
    float* snp = p.out + O_SGLA + (size_t)((i * 4 + h) * 128) * 256 + dv;
    const float v = vv[dv]; const float op = gla_state_step(s0p, snp, eg, kk, qt, v, half * 64);
    red2[tid] = op;
    __syncthreads();
    if (half == 0) { const float o = red2[tid] + red2[tid + 256] + qk * v; Og[(size_t)row * 1024 + h * 256 + dv] = f2bf(o); }
    __syncthreads();
}

__device__ __forceinline__ void swa_sample_unit(const Params& p, unsigned char* smem, int unit) {
    const int tid = threadIdx.x, lane = tid & 63, w = tid >> 6; const int i = unit >> 2, kvh = unit & 3, row = R_SAMP + i;
    float* qv = (float*)smem; float* knew = qv + 256; float* vnew = knew + 64; float* sc = vnew + 64; float* invd = sc + 4 * 144; float* red2 = invd + 4;
    const bf16_t* ur = (const bf16_t*)(p.ws + WS_UH) + (size_t)row * UW;
    bf16_t* O = (bf16_t*)(p.ws + WS_O);
    const float* cmk = p.in[2]; const float* cmv = p.in[3]; const float* cwk = p.in[4]; const float* cwv = p.in[5];
    __syncthreads();
    if (tid < 256) qv[tid] = bf2f(ur[U_SQ + kvh * 256 + tid]) * 0.125f;
    else if (tid < 320) knew[tid - 256] = bf2f(ur[U_SK + kvh * 64 + (tid - 256)]);
    else if (tid < 384) vnew[tid - 320] = bf2f(ur[U_SV + kvh * 64 + (tid - 320)]);
    __syncthreads();
    for (int idx = tid; idx < 576; idx += 512) {
        const int g = idx / 144, key = idx % 144; const float slope = exp2f(-0.5f * (float)(kvh * 4 + g + 1));
        float s = 0.f, biasv = 0.f;
        if (key == 143) { for (int c = 0; c < 64; ++c) s += qv[g * 64 + c] * knew[c]; }
        else {
            const float* kp;
            if (key < 16) kp = cmk + (size_t)((i * 16 + key) * 4 + kvh) * 64;
            else { const int c = key - 15; kp = cwk + (size_t)((i * 128 + c) * 4 + kvh) * 64; biasv = slope * (float)(128 - c); }
#pragma unroll 4
            for (int c4 = 0; c4 < 16; ++c4) { const f32x4 kvv = ((const f32x4*)kp)[c4]; const float* q4 = qv + g * 64 + 4 * c4;
                s += (q4[0] * kvv[0] + q4[1] * kvv[1]) + (q4[2] * kvv[2] + q4[3] * kvv[3]); }
        }
        sc[g * 144 + key] = s - biasv;
    }
    __syncthreads();
    if (w < 4) {
        const int g = w; const float sink = p.in[17][kvh * 4 + g];
        float m = -1e30f;
        for (int key = lane; key < 144; key += 64) m = fmaxf(m, sc[g * 144 + key]);
        m = fmaxf(wave_max(m), sink);
        float sum = 0.f;
        for (int key = lane; key < 144; key += 64) { const float e = __expf(sc[g * 144 + key] - m); sc[g * 144 + key] = e; sum += e; }
        sum = wave_sum(sum);
        if (lane == 0) invd[g] = 1.f / (sum + __expf(sink - m));
    }
    __syncthreads();
    {
        const int g = (tid >> 6) & 3, dv = tid & 63, half = tid >> 8; float op = 0.f;
        const float* scg = sc + g * 144;
        if (half == 0) {
            const float* mv = cmv + (size_t)(i * 16 * 4 + kvh) * 64 + dv;
#pragma unroll
            for (int key = 0; key < 16; ++key) op += scg[key] * mv[(size_t)key * 256];
            const float* wv = cwv + (size_t)((i * 128 + 1) * 4 + kvh) * 64 + dv;
#pragma unroll 8
            for (int c = 0; c < 56; ++c) op += scg[16 + c] * wv[(size_t)c * 256];
        } else {
            const float* wv = cwv + (size_t)((i * 128 + 57) * 4 + kvh) * 64 + dv;
#pragma unroll 8
            for (int c = 0; c < 71; ++c) op += scg[72 + c] * wv[(size_t)c * 256];
            op += scg[143] * vnew[dv];
        }
        red2[tid] = op;
    }
    __syncthreads();
    if (tid < 256) { const int g = tid >> 6, dv = tid & 63; O[(size_t)row * 1024 + (kvh * 4 + g) * 64 + dv] = f2bf((red2[tid] + red2[tid + 256]) * invd[g]); }
    float* owk = p.out + O_SWK; float* owv = p.out + O_SWV;
    for (int ib = 0; ib < 16; ib += 8) {
        float kb[8], vb[8];
#pragma unroll
        for (int it = 0; it < 8; ++it) {
            const int idx = tid + 512 * (ib + it), c = idx >> 6, e = idx & 63;
            if (c < 127) { const size_t si = (size_t)((i * 128 + c + 1) * 4 + kvh) * 64 + e; kb[it] = cwk[si]; vb[it] = cwv[si]; }
            else { kb[it] = knew[e]; vb[it] = vnew[e]; }
        }
#pragma unroll
        for (int it = 0; it < 8; ++it) {
            const int idx = tid + 512 * (ib + it), c = idx >> 6, e = idx & 63; const size_t di = (size_t)((i * 128 + c) * 4 + kvh) * 64 + e;
            owk[di] = kb[it]; owv[di] = vb[it];
        }
    }
    __syncthreads();
}

__device__ __forceinline__ void phase_mixer_a(const Params& p, unsigned char* smem) {
    const int G = gridDim.x, bid = blockIdx.x;
    for (int u = bid; u < 512; u += G) gla_prep_item(p, smem, u);
}
__device__ __forceinline__ void phase_mixer_b(const Params& p, unsigned char* smem) {
    const int G = gridDim.x, bid = blockIdx.x;
    for (int u = bid; u < 128; u += G) gla_scan_unit(p, smem, ((u & 7) << 4) | (u >> 3));
    const bool split = G >= 256;
    if (split && bid < 128) return;
    const int vb = split ? bid - 128 : bid, nb = split ? G - 128 : G;
    for (int u = vb; u < 256; u += nb) swa_prompt_unit(p, smem, u);
    for (int u = vb; u < 128; u += nb) gla_sample_unit(p, smem, u);
    for (int u = vb; u < 128; u += nb) swa_sample_unit(p, smem, u);
}

__device__ __forceinline__ void phase_gnorm(const Params& p) {
    const int tid = threadIdx.x, lane = tid & 63, wave = tid >> 6;
    const int gw = blockIdx.x * 8 + wave, NGW = gridDim.x * 8;
    const bf16_t* U = (const bf16_t*)(p.ws + WS_UH); bf16_t* Og = (bf16_t*)(p.ws + WS_OG); const float* onorm = p.in[15];
    for (int ri = gw; ri < NPR + 32; ri += NGW) {
        const int row = ri < NPR ? ri : R_SAMP + (ri - NPR);
#pragma unroll
        for (int hh = 0; hh < 4; ++hh) {
            const int col = hh * 256 + 4 * lane;
            u32x2* op = (u32x2*)(Og + (size_t)row * 1024 + col);
            const u32x2 ow = *op; const u32x2 gw2 = *(const u32x2*)(U + (size_t)row * UW + U_GR + col);
            const f32x4 on = *(const f32x4*)(onorm + col);
            const float o0 = bflo(ow.x), o1 = bfhi(ow.x), o2 = bflo(ow.y), o3 = bfhi(ow.y);
            const float ss = wave_sum((o0 * o0 + o1 * o1) + (o2 * o2 + o3 * o3));
            const float rs = rsqrtf(ss * (1.f / 256.f) + EPSV);
            f32x4 v; v[0] = o0 * rs * on[0] * siluf_(bflo(gw2.x)); v[1] = o1 * rs * on[1] * siluf_(bfhi(gw2.x));
            v[2] = o2 * rs * on[2] * siluf_(bflo(gw2.y)); v[3] = o3 * rs * on[3] * siluf_(bfhi(gw2.y));
            *op = pack4(v);
        }
    }
    const int gt = blockIdx.x * 512 + tid, NT = gridDim.x * 512;
    for (int idx = gt; idx < 2 * 16384 + 2 * 131072; idx += NT) {
        if (idx < 32768) { const int which = idx >> 14, r = idx & 16383, m = (r >> 8) & 15, col = r & 255;
            p.out[(which ? O_PMV : O_PMK) + r] = bf2f(U[(size_t)(R_META + m) * UW + (which ? U_SV : U_SK) + col]); }
        else { const int r2 = idx - 32768, which = r2 >> 17, r = r2 & 131071, b = r >> 15, j = (r >> 8) & 127, col = r & 255;
            p.out[(which ? O_PWV : O_PWK) + r] = bf2f(U[(size_t)(b * 2048 + 1920 + j) * UW + (which ? U_SV : U_SK) + col]); }
    }
}

__device__ __forceinline__ void phase_final(const Params& p) {
    const int tid = threadIdx.x, lane = tid & 63, wave = tid >> 6;
    const int gw = blockIdx.x * 8 + wave, NGW = gridDim.x * 8;
    const float* fn = p.in[24]; const float* hx = (const float*)(p.ws + WS_HX);
    for (int ri = gw; ri < NPR + 32; ri += NGW) {
        const float* src = ri < NPR ? p.out + O_YP + (size_t)ri * DM : hx + (size_t)(R_SAMP - NPR + (ri - NPR)) * DM;
        float* dst = ri < NPR ? p.out + O_YP + (size_t)ri * DM : p.out + O_YS + (size_t)(ri - NPR) * DM;
        f32x4 v[8]; float s = 0.f;
#pragma unroll
        for (int j = 0; j < 8; ++j) { v[j] = ((const f32x4*)src)[lane + 64 * j]; s += (v[j][0] * v[j][0] + v[j][1] * v[j][1]) + (v[j][2] * v[j][2] + v[j][3] * v[j][3]); }
        const float rs = rsqrtf(wave_sum(s) * (1.f / 2048.f) + EPSV);
#pragma unroll
        for (int j = 0; j < 8; ++j) ((f32x4*)dst)[lane + 64 * j] = v[j] * rs * ((const f32x4*)fn)[lane + 64 * j];
    }
}

typedef const __attribute__((address_space(4))) Params* KParams;
__global__ void __launch_bounds__(512, 2) mega_fwd(Params p_arg) {
    extern __shared__ __attribute__((aligned(16))) unsigned char smem[];
    cg::grid_group grid = cg::this_grid();
    const int ph_lo = p_arg.ph_lo, ph_hi = p_arg.ph_hi;
    volatile LAS unsigned* xst = (volatile LAS unsigned*)((PG8_LAS unsigned char*)smem + 131072);
    if (threadIdx.x == 0) { xst[0] = 0u; xst[1] = 0u; }
    __syncthreads();
    const XcdBarrier xb = xcd_barrier_post((unsigned*)(p_arg.ws + WS_BAR), xst);
#ifndef REP_MASK
#define REP_MASK 0x000
#endif
#ifndef PHMASK
#define PHMASK 0xfff
#endif
#define PHASE(n, ...) if constexpr ((PHMASK >> (n)) & 1) if (ph_lo <= (n) && (n) < ph_hi) { if ((n) > ph_lo) xcd_barrier(xb); \
        KParams kp = (KParams)__builtin_amdgcn_kernarg_segment_ptr(); asm volatile("" : "+s"(kp) :: "memory"); const Params& p = *(const Params*)kp; \
        PG8_LAS unsigned char* lds = (PG8_LAS unsigned char*)smem; unsigned char* ws = p.ws; (void)lds; (void)ws; \
        bf16_t* Abuf = (bf16_t*)(ws + WS_A); bf16_t* UH = (bf16_t*)(ws + WS_UH); bf16_t* Og = (bf16_t*)(ws + WS_OG); bf16_t* Ob = (bf16_t*)(ws + WS_O); \
        float* part = (float*)(ws + WS_PART); float* hx = (float*)(ws + WS_HX); float* partx = (float*)(ws + WS_PARTX); float* hmain = p.out + O_YP; (void)partx; (void)Abuf; (void)UH; (void)Og; (void)Ob; (void)part; (void)hx; (void)hmain; \
        { __VA_ARGS__ } if constexpr ((REP_MASK >> (n)) & 1) { asm volatile("" ::: "memory"); __VA_ARGS__ } }
    PHASE(0, phase_pre(p, smem);)
    PHASE(1, Epi<0> E{}; E.outb = UH; E.part_in = part; run_gemm<0>(lds, Abuf, (const bf16_t*)(ws + WS_BT1IN), RT, 11264, 2048, E);
             convert_in_tail(p, smem, 33 * 44, IT_PRE_END, IT_1OUT_END); convert_in_tail(p, smem, 33 * 44, IT_MIX_END, IT_2IN_SPLIT);)
#ifdef EXP_G2
    PHASE(2, Epi<1> E{}; E.outb = Abuf; E.hmain = hmain; E.hx = hx; E.part_out = part + RT; E.gvec = nullptr; E.scale = 0.25f; run_gemm<1>(lds, UH, (const bf16_t*)(ws + WS_BT1OUT), NPR, 2048, 5632, E);
             E.gvec = p.in[11]; run_gemm<1>(lds, UH, (const bf16_t*)(ws + WS_BT1OUT), NPR, 2048, 5632, E);
             skinny_phase<1>(smem, UH + (size_t)NPR * FF, FF, (const bf16_t*)(ws + WS_BT1OUT), 5632, nullptr, nullptr, Abuf, hx, part + RT, p.in[11], 0.5f, nullptr, nullptr);)
#else
    PHASE(2, Epi<1> E{}; E.outb = Abuf; E.hmain = hmain; E.hsrc = p.in[0]; E.hx = hx; E.part_out = part + RT; E.gvec = p.in[11]; E.scale = 0.5f; run_gemm<1>(lds, UH, (const bf16_t*)(ws + WS_BT1OUT), NPR, 2048, 5632, E);
             skinny_phase<1>(smem, UH + (size_t)NPR * FF, FF, (const bf16_t*)(ws + WS_BT1OUT), 5632, nullptr, nullptr, Abuf, hx, part + RT, p.in[11], 0.5f, nullptr, nullptr);)
#endif
    PHASE(3, Epi<2> E{}; E.outb = UH; E.part_in = part + RT; run_gemm<2>(lds, Abuf, (const bf16_t*)(ws + WS_BTIN), RT, NIN_PAD, 2048, E);
             convert_in_tail(p, smem, 33 * 35, IT_1OUT_END, IT_MIX_END); convert_in_tail(p, smem, 33 * 35, IT_2IN_SPLIT, IT_2IN_END);)
    PHASE(4, phase_mixer_a(p, smem);)
    PHASE(5, phase_mixer_b(p, smem);)
    PHASE(6, phase_gnorm(p);)
    PHASE(7, Epi<3> E3{}; E3.outb = Abuf; E3.U = UH; E3.gbias = p.in[19]; E3.uoff = U_GA; E3.boff = 0; run_gemm<3>(lds, Og, (const bf16_t*)(ws + WS_BTGO), NPR, 2048, 1024, E3);
             Epi<4> E4{}; E4.outb = Abuf; E4.U = UH; E4.gbias = p.in[19]; E4.uoff = U_GB; E4.boff = DM; run_gemm<4>(lds, Ob, (const bf16_t*)(ws + WS_BTSO), NPR, 2048, 1024, E4);
             skinny_phase<34>(smem, Og + (size_t)NPR * 1024, 1024, (const bf16_t*)(ws + WS_BTGO), 1024, Ob + (size_t)NPR * 1024, (const bf16_t*)(ws + WS_BTSO), Abuf, nullptr, nullptr, nullptr, 0.f, UH, p.in[19]);)
    PHASE(8, Epi<1> E{}; E.outb = Og; E.hmain = hmain; E.hsrc = hmain; E.hx = hx; E.part_out = part + 2 * RT; E.gvec = p.in[21]; E.scale = 1.0f; run_gemm<1>(lds, Abuf, (const bf16_t*)(ws + WS_BTOUT), NPR, 2048, 2048, E);
             skinny_phase<1>(smem, Abuf + (size_t)NPR * DM, DM, (const bf16_t*)(ws + WS_BTOUT), 2048, nullptr, nullptr, Og, hx, part + 2 * RT, p.in[21], 1.0f, nullptr, nullptr);)
    PHASE(9, Epi<0> E{}; E.outb = UH; E.part_in = part + 2 * RT; run_gemm<0>(lds, Og, (const bf16_t*)(ws + WS_BT2IN), RT, 11264, 2048, E);
             convert_in_tail(p, smem, 33 * 44, IT_2IN_END, IT_END);)
    const bool fused_final = (gridDim.x == 256);
    PHASE(10, if (fused_final) {
                 Epi<5> E{}; E.hmain = hmain; E.hsrc = hmain; E.part_out = part + 3 * RT; E.scale = 0.5f; E.cnt = (unsigned*)(ws + WS_CNT); E.fnorm = p.in[24];
                 run_gemm<5>(lds, UH, (const bf16_t*)(ws + WS_BT2OUT), NPR, 2048, 5632, E);
                 skinny_phase<15>(smem, UH + (size_t)NPR * FF, FF, (const bf16_t*)(ws + WS_BT2OUT), 5632, nullptr, nullptr, nullptr, hx, part + 3 * RT, nullptr, 0.5f, nullptr, nullptr, (unsigned*)(ws + WS_CNT) + 64 * 36, p.in[24], p.out + O_YS);
             } else {
                 Epi<1> E{}; E.outb = nullptr; E.hmain = hmain; E.hsrc = hmain; E.hx = hx; E.part_out = nullptr; E.gvec = nullptr; E.scale = 0.5f; run_gemm<1>(lds, UH, (const bf16_t*)(ws + WS_BT2OUT), NPR, 2048, 5632, E);
                 skinny_phase<1>(smem, UH + (size_t)NPR * FF, FF, (const bf16_t*)(ws + WS_BT2OUT), 5632, nullptr, nullptr, nullptr, hx, partx, nullptr, 0.5f, nullptr, nullptr);
             })
    if (!fused_final) { PHASE(11, phase_final(p);) }
#undef PHASE
}

extern "C" void kernel_launch(void* const* d_in, const int* in_sizes, int n_in, void* d_out, int out_size, void* d_ws, size_t ws_size, hipStream_t stream) {
    static int grid = 0;
    if (grid == 0) {
        if (n_in != 25 || out_size != 23953408 || ws_size < WS_END) { fprintf(stderr, "kernel_launch: unexpected shapes n_in %d out %d ws %zu (need %zu)\n", n_in, out_size, ws_size, (size_t)WS_END); grid = -1; return; }
        int dev = 0, cus = 0, per_cu = 0;
        hipGetDevice(&dev); hipDeviceGetAttribute(&cus, hipDeviceAttributeMultiprocessorCount, dev);
        if (hipFuncSetAttribute((const void*)mega_fwd, hipFuncAttributeMaxDynamicSharedMemorySize, LDS_BYTES) != hipSuccess) { fprintf(stderr, "kernel_launch: hipFuncSetAttribute failed\n"); grid = -1; return; }
        hipOccupancyMaxActiveBlocksPerMultiprocessor(&per_cu, (const void*)mega_fwd, 512, LDS_BYTES);
        if (per_cu < 1) { fprintf(stderr, "kernel_launch: occupancy query says %d blocks per CU\n", per_cu); per_cu = 1; }
        (void)hipGetLastError();
        grid = cus;
        if (grid > 256) grid = 256;
    }
    if (grid < 0) return;
    if (hipMemsetAsync((char*)d_ws + WS_BAR, 0, (size_t)(XCD_BAR_WORDS + CNT_WORDS) * 4, stream) != hipSuccess) { fprintf(stderr, "kernel_launch: memset of the barrier words failed\n"); return; }
    Params p{};
    for (int i = 0; i < 25; ++i) p.in[i] = (const float*)d_in[i];
    p.out = (float*)d_out; p.ws = (unsigned char*)d_ws;
#if MK_LAUNCHES == 1
    p.ph_lo = 0; p.ph_hi = NPHASE;
    void* args[] = {&p};
    hipError_t e = hipLaunchCooperativeKernel((const void*)mega_fwd, dim3(grid), dim3(512), args, LDS_BYTES, stream);
    if (e != hipSuccess) fprintf(stderr, "cooperative launch failed: %s (grid %d)\n", hipGetErrorString(e), grid);
#else
    for (int ph = 0; ph < NPHASE; ++ph) { p.ph_lo = ph; p.ph_hi = ph + 1; hipLaunchKernelGGL(mega_fwd, dim3(grid), dim3(512), LDS_BYTES, stream, p); }
#endif
}
```

```cpp
#include <hip/hip_runtime.h>
#include <hip/hip_cooperative_groups.h>
#include <cstdio>
#include <cstdint>
namespace cg = cooperative_groups;
#ifndef MK_LAUNCHES
#define MK_LAUNCHES 1
#endif
namespace pg8 {
#define PG8_LAS __attribute__((address_space(3)))
typedef unsigned short bf16_t;
typedef short bf16x8 __attribute__((ext_vector_type(8)));
typedef float f32x4 __attribute__((ext_vector_type(4)));
typedef unsigned u32x4 __attribute__((ext_vector_type(4)));
constexpr int BM = 256, BK = 64, HALF = 128, HTB = HALF * BK * 2  , STAGE_BYTES = 8 * HTB, NXCD = 8, WGM = 8;

__host__ __device__ __forceinline__ int lds_byte(int r, int c) { const int st = (r >> 4) * 2 + (c >> 5), rr = r & 15, cc = c & 31, ob = rr * 64 + cc * 2; return st * 1024 + (ob ^ (((ob >> 9) & 1) << 5)); }
__host__ __device__ __forceinline__ void stage_rc(int b, int& R, int& C) { const int st = b / 1024, sb = b % 1024, swz = sb ^ (((sb >> 9) & 1) << 5); R = (st >> 1) * 16 + swz / 64; C = (st & 1) * 32 + (swz % 64) / 2; }
__host__ __device__ __forceinline__ int perm32(int rho) { const int n = rho >> 4, i = rho & 15; return 8 * (i >> 2) + 4 * n + (i & 3); }
struct Unit { int pm, pn; };
struct Gemm { const bf16_t* A; const bf16_t* Bt; int M, N, K; };

struct StaticOrder {
    int nM, nN, nwg, G, c;
    __host__ __device__ void init(int M, int N, int G_, int c_) { nM = M / BM; nN = N / BM; nwg = nM * nN; G = G_; c = c_; }
    __host__ __device__ bool next(int i, Unit& u) const {
        const long L = (long)i * G + c; if (L >= nwg) return false;
        int wgid = (int)L; { const int q = nwg / NXCD, r = nwg % NXCD, xcd = wgid % NXCD, off = wgid / NXCD; wgid = (xcd < r ? xcd * (q + 1) : r * (q + 1) + (xcd - r) * q) + off; }
        const int nig = WGM * nN, gid = wgid / nig, fm = gid * WGM, gsz = (nM - fm) < WGM ? (nM - fm) : WGM;
        u.pm = fm + ((wgid % nig) % gsz); u.pn = (wgid % nig) / gsz; return true;
    }
    __device__ __forceinline__ void a_ready(const Unit&) const {}
    __device__ __forceinline__ void done(const Unit&) const {}
};
typedef __bf16 bf16v2_t __attribute__((ext_vector_type(2)));
typedef float f32v2_t __attribute__((ext_vector_type(2)));
__device__ __forceinline__ unsigned cvt_pk_bf16_c(float lo, float hi) { f32v2_t v = {lo, hi}; bf16v2_t b = __builtin_convertvector(v, bf16v2_t); unsigned r; __builtin_memcpy(&r, &b, 4); return r; }
__device__ __forceinline__ unsigned cvt_pk_bf16(float lo, float hi) { unsigned r; asm volatile("v_cvt_pk_bf16_f32 %0, %1, %2" : "=v"(r) : "v"(lo), "v"(hi)); return r; }
template <class Epi, class Sched, bool STAMP = false>
__device__ __forceinline__ void gemm_phase(PG8_LAS unsigned char* lds, const Gemm g, const Sched& S, const Epi& E, unsigned long long* stamps) {
    const int tid = threadIdx.x, wid = __builtin_amdgcn_readfirstlane(tid >> 6), lane = tid & 63, wr = wid >> 2, wc = wid & 3, fr = lane & 15, fq = lane >> 4;
    const int K = g.K, nt = K / BK;
    int ts_lo = 0, ts_hi = 0, nts = 0; const unsigned long long rt_entry = STAMP ? (unsigned long long)wall_clock64() : 0ull;
#define PG8_STAMP() do { if (STAMP && wid == 0 && nts < 64) { const unsigned long long _c = (unsigned long long)clock64(); \
        ts_lo = (lane == nts) ? (int)(unsigned)_c : ts_lo; ts_hi = (lane == nts) ? (int)(unsigned)(_c >> 32) : ts_hi; ++nts; } } while (0)
    PG8_STAMP();
    unsigned voffA[2], voffB[2];
#pragma unroll
    for (int i = 0; i < 2; ++i) { int R, C; stage_rc(tid * 16 + i * 8192, R, C); const int Rb = Epi::PERM ? ((R & ~31) + perm32(R & 31)) : R;
        voffA[i] = (unsigned)(R * K + C) * 2u; voffB[i] = (unsigned)(Rb * K + C) * 2u; }
    const size_t kstep = (size_t)(BK * 2);
    const size_t hstep = (size_t)HALF * K * 2;
    const size_t tstep = 2 * hstep;
    const unsigned ldsw = (unsigned)wid * 1024u;
    const int aoff = lds_byte(wr * 64 + fr, fq * 8), boff = lds_byte(wc * 32 + fr, fq * 8);
#define PG8_SA(b, h) (((b) * 2 + (h)) * HTB)
#define PG8_SB(b, h) ((4 + (b) * 2 + (h)) * HTB)
#define PG8_STAGE(bufoff, gbase, voff) do { _Pragma("unroll") for (int _i = 0; _i < 2; ++_i) \
        __builtin_amdgcn_global_load_lds((const unsigned*)((const char*)(gbase) + (voff)[_i]), (PG8_LAS unsigned*)(lds + (bufoff) + ldsw + _i * 8192), 16, 0, 0); } while (0)
#define PG8_LDA(dst, b, h) do { _Pragma("unroll") for (int m = 0; m < 4; ++m) _Pragma("unroll") for (int k = 0; k < 2; ++k) dst[m][k] = *(const PG8_LAS bf16x8*)(lds + PG8_SA(b, h) + aoff + m * 2048 + k * 1024); } while (0)
#define PG8_LDB(dst, b, h) do { _Pragma("unroll") for (int n = 0; n < 2; ++n) _Pragma("unroll") for (int k = 0; k < 2; ++k) dst[n][k] = *(const PG8_LAS bf16x8*)(lds + PG8_SB(b, h) + boff + n * 2048 + k * 1024); } while (0)
#define PG8_MMA(ai, bj, At, Bt) do { __builtin_amdgcn_s_setprio(1); _Pragma("unroll") for (int m = 0; m < 4; ++m) _Pragma("unroll") for (int n = 0; n < 2; ++n) _Pragma("unroll") for (int k = 0; k < 2; ++k) \
        acc[ai][bj][m][n] = __builtin_amdgcn_mfma_f32_16x16x32_bf16(Bt[n][k], At[m][k], acc[ai][bj][m][n], 0, 0, 0); __builtin_amdgcn_s_setprio(0); } while (0)
#define PG8_WAIT_V(n) asm volatile("s_waitcnt vmcnt(" #n ")" ::: "memory")
#define PG8_WAIT_L(n) asm volatile("s_waitcnt lgkmcnt(" #n ")" ::: "memory")
#define PG8_BAR __builtin_amdgcn_s_barrier()
#define PG8_SCHED __builtin_amdgcn_sched_barrier(0)
    Unit cur, nxt; int ui = 0;
    if (!S.next(0, cur)) return;
    f32x4 acc[2][2][4][2];
#pragma unroll
    for (int a = 0; a < 2; ++a)
#pragma unroll
        for (int b = 0; b < 2; ++b)
#pragma unroll
            for (int m = 0; m < 4; ++m)
#pragma unroll
                for (int n = 0; n < 2; ++n) acc[a][b][m][n] = (f32x4){0.f, 0.f, 0.f, 0.f};
    bf16x8 At[4][2], B0[2][2], B1[2][2];
    const char* cA = (const char*)g.A + (size_t)cur.pm * tstep; const char* cB = (const char*)g.Bt + (size_t)cur.pn * tstep;
    S.a_ready(cur);
    PG8_STAGE(PG8_SB(0, 0), cB, voffB); PG8_STAGE(PG8_SA(0, 0), cA, voffA); PG8_STAGE(PG8_SB(0, 1), cB + hstep, voffB); PG8_STAGE(PG8_SA(0, 1), cA + hstep, voffA);
    if (wr == 1) PG8_BAR;
    PG8_WAIT_V(4); PG8_BAR;
    PG8_STAGE(PG8_SB(1, 0), cB + kstep, voffB); PG8_STAGE(PG8_SA(1, 0), cA + kstep, voffA); PG8_STAGE(PG8_SB(1, 1), cB + hstep + kstep, voffB);
    PG8_WAIT_V(6); PG8_BAR;
    PG8_STAMP();
    for (;;) {
        const bool has_next = S.next(ui + 1, nxt);
        const char* nA = has_next ? (const char*)g.A + (size_t)nxt.pm * tstep : cA; const char* nB = has_next ? (const char*)g.Bt + (size_t)nxt.pn * tstep : cB;
        for (int t = 0; t < nt; t += 2) {
            const bool last = (t == nt - 2);
            const char* a1 = cA + (size_t)(t + 1) * kstep;
            const char* a2 = last ? nA : cA + (size_t)(t + 2) * kstep; const char* b2 = last ? nB : cB + (size_t)(t + 2) * kstep;
            const char* a3 = a2 + kstep; const char* b3 = b2 + kstep;
            if (last && has_next) S.a_ready(nxt);
            PG8_LDB(B0, 0, 0); PG8_SCHED; PG8_LDA(At, 0, 0); PG8_STAGE(PG8_SA(1, 1), a1 + hstep, voffA);
            PG8_WAIT_L(8); PG8_BAR; PG8_WAIT_L(0); PG8_MMA(0, 0, At, B0); PG8_BAR; PG8_SCHED;
            PG8_LDB(B1, 0, 1); PG8_STAGE(PG8_SB(0, 0), b2, voffB);
            PG8_BAR; PG8_WAIT_L(0); PG8_MMA(0, 1, At, B1); PG8_BAR;
            PG8_LDA(At, 0, 1); PG8_STAGE(PG8_SA(0, 0), a2, voffA);
            PG8_BAR; PG8_WAIT_L(0); PG8_MMA(1, 0, At, B0); PG8_BAR; PG8_SCHED;
            PG8_STAGE(PG8_SB(0, 1), b2 + hstep, voffB);
            PG8_WAIT_V(6); PG8_BAR; PG8_MMA(1, 1, At, B1); PG8_BAR;
            PG8_LDB(B0, 1, 0); PG8_SCHED; PG8_LDA(At, 1, 0); PG8_STAGE(PG8_SA(0, 1), a2 + hstep, voffA);
            PG8_WAIT_L(8); PG8_BAR; PG8_WAIT_L(0); PG8_MMA(0, 0, At, B0); PG8_BAR; PG8_SCHED;
            PG8_LDB(B1, 1, 1); PG8_STAGE(PG8_SB(1, 0), b3, voffB);
            PG8_BAR; PG8_WAIT_L(0); PG8_MMA(0, 1, At, B1); PG8_BAR;
            PG8_LDA(At, 1, 1); PG8_STAGE(PG8_SA(1, 0), a3, voffA);
            PG8_BAR; PG8_WAIT_L(0); PG8_MMA(1, 0, At, B0); PG8_BAR; PG8_SCHED;
            PG8_STAGE(PG8_SB(1, 1), b3 + hstep, voffB);
            PG8_WAIT_V(6); PG8_BAR; PG8_MMA(1, 1, At, B1); PG8_BAR;
        }
        PG8_STAMP();
        if constexpr (!Epi::AFTER_DRAIN) { E(acc, cur, wr, wc, fr, fq); S.done(cur); }
        PG8_STAMP();
        if (!has_next) break;
#pragma unroll
        for (int a = 0; a < 2; ++a)
#pragma unroll
            for (int b = 0; b < 2; ++b)
#pragma unroll
                for (int m = 0; m < 4; ++m)
#pragma unroll
                    for (int n = 0; n < 2; ++n) acc[a][b][m][n] = (f32x4){0.f, 0.f, 0.f, 0.f};
        cur = nxt; cA = nA; cB = nB; ++ui;
    }
    PG8_WAIT_V(0);
    if (wr == 0) PG8_BAR;
    PG8_BAR;
    if constexpr (Epi::AFTER_DRAIN) { E.fused(acc, cur, wr, wc, fr, fq, lds, wid, lane); S.done(cur); }
    PG8_STAMP();
    if (STAMP && wid == 0) { stamps[lane] = lane < nts ? (((unsigned long long)(unsigned)ts_hi << 32) | (unsigned)ts_lo) : 0ull;
        if (lane == 62) stamps[62] = rt_entry; if (lane == 63) stamps[63] = (unsigned long long)wall_clock64(); }
#undef PG8_STAMP
#undef PG8_SA
#undef PG8_SB
#undef PG8_STAGE
#undef PG8_LDA
#undef PG8_LDB
#undef PG8_MMA
#undef PG8_WAIT_V
#undef PG8_WAIT_L
#undef PG8_BAR
#undef PG8_SCHED
}
}

#define XB_TMO      128
#define XB_XCNT(j)  (256  + 64 * (j))
#define XB_XSUB(j)  (1280 + 64 * (j))
#define XB_XGEN(j)  (2304 + 64 * (j))
#define XB_TOP      3328
#define XB_TOPGEN   3392
#define XCD_BAR_WORDS 3456
#define XB_SPIN_CAP (1u << 18)
#define LAS __attribute__((address_space(3)))

__device__ __forceinline__ unsigned xb_ld(unsigned* p)              { return __hip_atomic_load(p, __ATOMIC_RELAXED, __HIP_MEMORY_SCOPE_AGENT); }
__device__ __forceinline__ unsigned xb_add(unsigned* p, unsigned v) { return __hip_atomic_fetch_add(p, v, __ATOMIC_RELAXED, __HIP_MEMORY_SCOPE_AGENT); }
__device__ __forceinline__ unsigned xb_xcc_id() { return (unsigned)__builtin_amdgcn_s_getreg((3 << 11) | 20) & 0xFu; }
#define XB_SPIN(cond, bar) do { unsigned _sp = 0; while (cond) { __builtin_amdgcn_s_sleep(1); \
    if ((++_sp & 255u) == 0u) { if (xb_ld(&(bar)[XB_TMO])) break; if (_sp > XB_SPIN_CAP) { atomicAdd(&(bar)[XB_TMO], 1u); break; } } } } while (0)

struct XcdBarrier {
    unsigned* bar; unsigned x;
    volatile LAS unsigned* st;
};

__device__ __forceinline__ XcdBarrier xcd_barrier_post(unsigned* bar, volatile LAS unsigned* st) {
    XcdBarrier b; b.bar = bar; b.x = xb_xcc_id(); b.st = st;
    if (threadIdx.x == 0) (void)xb_add(&bar[XB_XCNT(b.x)], 1u);
    return b;
}
__device__ __forceinline__ void xcd_barrier_complete(unsigned* bar, unsigned x, unsigned& nloc, unsigned& nx) {
    const unsigned G = gridDim.x * gridDim.y * gridDim.z;
    unsigned sum, cnt, mine, sp = 0u;
    for (;;) {
        sum = 0u; cnt = 0u; mine = 0u;
#pragma unroll
        for (unsigned j = 0; j < 16; ++j) { const unsigned c = xb_ld(&bar[XB_XCNT(j)]); sum += c; cnt += (c > 0u) ? 1u : 0u; mine = (j == x) ? c : mine; }
        if (sum == G) break;
        __builtin_amdgcn_s_sleep(1);
        if ((++sp & 255u) == 0u) { if (xb_ld(&bar[XB_TMO])) break; if (sp > XB_SPIN_CAP) { atomicAdd(&bar[XB_TMO], 1u); break; } }
    }
    nloc = mine > 0u ? mine : 1u; nx = cnt > 0u ? cnt : 1u;
}

__device__ __forceinline__ void xcd_barrier(const XcdBarrier& b) {
    asm volatile("s_waitcnt vmcnt(0)" ::: "memory");
    __syncthreads();
    if (threadIdx.x == 0) {
        unsigned* bar = b.bar;
        __builtin_amdgcn_s_waitcnt(0);
        unsigned nloc = b.st[0], nx = b.st[1];
        if (nloc == 0u) { xcd_barrier_complete(bar, b.x, nloc, nx); b.st[0] = nloc; b.st[1] = nx; }
        const unsigned old = xb_add(&bar[XB_XSUB(b.x)], 1u);
        const unsigned gen = old / nloc;
        if (old + 1u == (gen + 1u) * nloc) {
            __builtin_amdgcn_fence(__ATOMIC_RELEASE, "agent");
            asm volatile("s_waitcnt vmcnt(0)" ::: "memory");
            const unsigned og = xb_add(&bar[XB_TOP], 1u);
            const unsigned tg = og / nx;
            if (og + 1u == (tg + 1u) * nx) xb_add(&bar[XB_TOPGEN], 1u);
            else XB_SPIN(xb_ld(&bar[XB_TOPGEN]) == tg, bar);
            __builtin_amdgcn_fence(__ATOMIC_ACQUIRE, "agent");
            xb_add(&bar[XB_XGEN(b.x)], 1u);
            asm volatile("s_waitcnt vmcnt(0)" ::: "memory");
        } else {
            XB_SPIN(xb_ld(&bar[XB_XGEN(b.x)]) == gen, bar);
            __builtin_amdgcn_fence(__ATOMIC_ACQUIRE, "agent");
            asm volatile("s_waitcnt vmcnt(0)" ::: "memory");
        }
    }
    __syncthreads();
}


using pg8::bf16_t; using pg8::bf16x8; using pg8::f32x4; using pg8::u32x4; using pg8::cvt_pk_bf16;
typedef unsigned u32x2 __attribute__((ext_vector_type(2)));
constexpr int DM = 2048, FF = 5632, NPR = 8192, R_META = 8192, R_SAMP = 8208, RT = 8448;
constexpr int UW = 8720;
constexpr int U_GQ = 0, U_GK = 512, U_GV = 1024, U_GR = 2048, U_SQ = 3072, U_SK = 4096, U_SV = 4352, U_GA = 4608, U_GB = 6656, U_GAD = 8704;
constexpr int NIN_PAD = 8960;
constexpr float EPSV = 1e-6f;
constexpr size_t O_YP = 0, O_YS = 16777216, O_PMK = 16842752, O_PMV = 16859136, O_PWK = 16875520, O_PWV = 17006592, O_PGLA = 17137664,
                 O_SWK = 17661952, O_SWV = 18710528, O_SGLA = 19759104;
constexpr size_t WS_BT1IN = 0;
constexpr size_t WS_BT1OUT = WS_BT1IN + (size_t)11264 * 2048 * 2;
constexpr size_t WS_BTIN = WS_BT1OUT + (size_t)2048 * 5632 * 2;
constexpr size_t WS_BTGO = WS_BTIN + (size_t)NIN_PAD * 2048 * 2;
constexpr size_t WS_BTSO = WS_BTGO + (size_t)2048 * 1024 * 2;
constexpr size_t WS_BTOUT = WS_BTSO + (size_t)2048 * 1024 * 2;
constexpr size_t WS_BT2IN = WS_BTOUT + (size_t)2048 * 2048 * 2;
constexpr size_t WS_BT2OUT = WS_BT2IN + (size_t)11264 * 2048 * 2;
constexpr size_t WS_A = WS_BT2OUT + (size_t)2048 * 5632 * 2;
constexpr size_t WS_UH = WS_A + (size_t)RT * 2048 * 2;
constexpr size_t WS_OG = WS_UH + (size_t)RT * UW * 2;
constexpr size_t WS_O = WS_OG + (size_t)RT * 1024 * 2;
constexpr size_t WS_PART = WS_O + (size_t)RT * 1024 * 2;
constexpr size_t WS_HX = WS_PART + (size_t)RT * 32 * 4;
constexpr size_t WS_PARTX = WS_HX + (size_t)256 * 2048 * 4;
constexpr size_t WS_QT = WS_PARTX + (size_t)64 * 128 * 4;
constexpr size_t WS_KH = WS_QT + (size_t)512 * 8192 * 2;
constexpr size_t WS_ATT = WS_KH + (size_t)512 * 8192 * 2;
constexpr size_t WS_DEC = WS_ATT + (size_t)512 * 4096 * 2;
constexpr size_t WS_BAR = WS_DEC + (size_t)512 * 128 * 4;
constexpr int CNT_WORDS = 64 * 40;
constexpr size_t WS_CNT = WS_BAR + (size_t)XCD_BAR_WORDS * 4;
constexpr size_t WS_VC = WS_CNT + (size_t)CNT_WORDS * 4;
constexpr size_t WS_END = WS_VC + (size_t)512 * 16384 * 2;
constexpr int LDS_BYTES = 131072 + 16;
constexpr int NPHASE = 12;

struct Params { const float* in[25]; float* out; unsigned char* ws; int ph_lo, ph_hi; };

__device__ __forceinline__ float bf2f(unsigned short b) { return __uint_as_float(((unsigned)b) << 16); }
__device__ __forceinline__ float bflo(unsigned w) { return __uint_as_float(w << 16); }
__device__ __forceinline__ float bfhi(unsigned w) { return __uint_as_float(w & 0xffff0000u); }
__device__ __forceinline__ unsigned short f2bf(float f) { return (unsigned short)(cvt_pk_bf16(f, 0.f) & 0xffffu); }
__device__ __forceinline__ float wave_sum(float v) {
#pragma unroll
    for (int o = 1; o < 64; o <<= 1) v += __shfl_xor(v, o);
    return v;
}
__device__ __forceinline__ float wave_max(float v) {
#pragma unroll
    for (int o = 1; o < 64; o <<= 1) v = fmaxf(v, __shfl_xor(v, o));
    return v;
}
__device__ __forceinline__ float sigmoidf_(float x) { return 1.f / (1.f + __expf(-x)); }
__device__ __forceinline__ float siluf_(float x) { return x / (1.f + __expf(-x)); }
__device__ __forceinline__ float logsigf_(float x) { return fminf(x, 0.f) - log1pf(__expf(-fabsf(x))); }
__device__ __forceinline__ f32x4 mfma16(bf16x8 a, bf16x8 b, f32x4 c) { return __builtin_amdgcn_mfma_f32_16x16x32_bf16(a, b, c, 0, 0, 0); }
__device__ __forceinline__ u32x2 pack4(f32x4 v) { u32x2 r; r.x = cvt_pk_bf16(v[0], v[1]); r.y = cvt_pk_bf16(v[2], v[3]); return r; }
__device__ __forceinline__ u32x2 pack4c(f32x4 v) { u32x2 r; r.x = pg8::cvt_pk_bf16_c(v[0], v[1]); r.y = pg8::cvt_pk_bf16_c(v[2], v[3]); return r; }
__device__ __forceinline__ float rstd_of(const float* part, int row) {
    const f32x4* p = (const f32x4*)(part + (size_t)row * 32);
    f32x4 s = p[0];
#pragma unroll
    for (int i = 1; i < 8; ++i) s += p[i];
    return rsqrtf(((s[0] + s[1]) + (s[2] + s[3])) * (1.f / 2048.f) + EPSV);
}

__device__ __forceinline__ float rstd_x(const float* partx, int row) {
    const int rl = row - NPR; if (rl >= 64) return 1.f;
    const f32x4* p = (const f32x4*)(partx + (size_t)rl * 128);
    f32x4 s = p[0];
#pragma unroll
    for (int i = 1; i < 32; ++i) s += p[i];
    return rsqrtf(((s[0] + s[1]) + (s[2] + s[3])) * (1.f / 2048.f) + EPSV);
}

template <int MODE> struct Epi {
    static constexpr bool PERM = false, AFTER_DRAIN = (MODE == 5);
    template <class LP> __device__ __forceinline__ void fused(const f32x4 (&acc)[2][2][4][2], const pg8::Unit& u, int wr, int wc, int fr, int fq, LP, int, int) const { (*this)(acc, u, wr, wc, fr, fq); }
    bf16_t* outb; float* hmain; const float* hsrc; float* hx; const float* part_in; const float* partx; float* part_out; const float* gvec; const bf16_t* U; const float* gbias; float scale; int uoff, boff; unsigned* cnt; const float* fnorm;
    __device__ __forceinline__ void operator()(const f32x4 (&acc)[2][2][4][2], const pg8::Unit& u, int wr, int wc, int fr, int fq) const {
        const int row0 = u.pm * 256 + wr * 64 + fr;
        if constexpr (MODE == 0) {
            float rsv[8];
#pragma unroll
            for (int i = 0; i < 8; ++i) rsv[i] = part_in[row0 + (i >> 2) * 128 + (i & 3) * 16];
#pragma unroll
            for (int i = 0; i < 8; ++i) rsv[i] = rsqrtf(rsv[i] * (1.f / 2048.f) + EPSV);
            const int j0 = u.pn * 128 + wc * 16 + 4 * fq;
#pragma unroll
            for (int ai = 0; ai < 2; ++ai)
#pragma unroll
                for (int m = 0; m < 4; ++m) {
                    const int row = row0 + ai * 128 + m * 16; const float rs = rsv[ai * 4 + m];
#pragma unroll
                    for (int bj = 0; bj < 2; ++bj) {
                        f32x4 a = acc[ai][bj][m][0] * rs, b = acc[ai][bj][m][1] * rs, hv;
#pragma unroll
                        for (int j = 0; j < 4; ++j) hv[j] = siluf_(a[j]) * b[j];
                        *(u32x2*)(outb + (size_t)row * FF + j0 + bj * 64) = pack4(hv);
                    }
                }
        } else if constexpr (MODE == 1) {
            float* hb = hmain; const float* hs = hsrc;
            const int col0 = u.pn * 256 + wc * 32 + 4 * fq;
            f32x4 gv[4];
#pragma unroll
            for (int q = 0; q < 4; ++q) gv[q] = gvec ? *(const f32x4*)(gvec + col0 + (q >> 1) * 128 + (q & 1) * 16) : (f32x4){0.f, 0.f, 0.f, 0.f};
            f32x4 hn[4];
#pragma unroll
            for (int q = 0; q < 4; ++q) hn[q] = *(const f32x4*)(hs + (size_t)row0 * DM + col0 + (q >> 1) * 128 + (q & 1) * 16);
#pragma unroll
            for (int i = 0; i < 8; ++i) {
                const int ai = i >> 2, m = i & 3, row = row0 + ai * 128 + m * 16; float ss = 0.f;
                f32x4 hc[4];
#pragma unroll
                for (int q = 0; q < 4; ++q) hc[q] = hn[q];
                if (i < 7) {
                    const int rown = row0 + ((i + 1) >> 2) * 128 + ((i + 1) & 3) * 16;
#pragma unroll
                    for (int q = 0; q < 4; ++q) hn[q] = *(const f32x4*)(hs + (size_t)rown * DM + col0 + (q >> 1) * 128 + (q & 1) * 16);
                }
#pragma unroll
                for (int q = 0; q < 4; ++q) {
                    const int bj = q >> 1, n = q & 1, col = col0 + bj * 128 + n * 16;
                    const f32x4 hv = hc[q] + acc[ai][bj][m][n] * scale;
                    *(f32x4*)(hb + (size_t)row * DM + col) = hv;
                    if (gvec) {
                        ss += (hv[0] * hv[0] + hv[1] * hv[1]) + (hv[2] * hv[2] + hv[3] * hv[3]);
                        *(u32x2*)(outb + (size_t)row * DM + col) = pack4(hv * gv[q]);
                    }
                }
                if (gvec) {
                    ss += __shfl_xor(ss, 16); ss += __shfl_xor(ss, 32);
                    if (fq == 0) unsafeAtomicAdd(part_out + row, ss);
                }
            }
        } else if constexpr (MODE == 5) {
            f32x4 (&hv)[2][2][4][2] = const_cast<f32x4 (&)[2][2][4][2]>(acc);
            float* hb = hmain; const float* hs = hsrc;
            const int col0 = u.pn * 256 + wc * 32 + 4 * fq;
            f32x4 hn[4];
#pragma unroll
            for (int q = 0; q < 4; ++q) hn[q] = *(const f32x4*)(hs + (size_t)row0 * DM + col0 + (q >> 1) * 128 + (q & 1) * 16);
#pragma unroll
            for (int i = 0; i < 8; ++i) {
                const int ai = i >> 2, m = i & 3, row = row0 + ai * 128 + m * 16; float ss = 0.f;
                f32x4 hc[4];
#pragma unroll
                for (int q = 0; q < 4; ++q) hc[q] = hn[q];
                if (i < 7) {
                    const int rown = row0 + ((i + 1) >> 2) * 128 + ((i + 1) & 3) * 16;
#pragma unroll
                    for (int q = 0; q < 4; ++q) hn[q] = *(const f32x4*)(hs + (size_t)rown * DM + col0 + (q >> 1) * 128 + (q & 1) * 16);
                }
#pragma unroll
                for (int q = 0; q < 4; ++q) {
                    const int bj = q >> 1, n = q & 1;
                    const f32x4 v = hc[q] + acc[ai][bj][m][n] * scale;
                    hv[ai][bj][m][n] = v;
                    ss += (v[0] * v[0] + v[1] * v[1]) + (v[2] * v[2] + v[3] * v[3]);
                }
                ss += __shfl_xor(ss, 16); ss += __shfl_xor(ss, 32);
                if (fq == 0) unsafeAtomicAdd(part_out + row, ss);
            }
            asm volatile("s_waitcnt vmcnt(0)" ::: "memory");
            unsigned* cw = cnt + 64 * u.pm;
            if (fr == 0 && fq == 0) (void)__hip_atomic_fetch_add(cw, 1u, __ATOMIC_RELAXED, __HIP_MEMORY_SCOPE_AGENT);
            { unsigned sp = 0; while ((unsigned)__builtin_amdgcn_readfirstlane(__hip_atomic_load(cw, __ATOMIC_RELAXED, __HIP_MEMORY_SCOPE_AGENT)) < 64u) { __builtin_amdgcn_s_sleep(2); if (++sp > (1u << 20)) break; } }
            f32x4 fv[4];
#pragma unroll
            for (int q = 0; q < 4; ++q) fv[q] = *(const f32x4*)(fnorm + col0 + (q >> 1) * 128 + (q & 1) * 16);
            float rsv[8];
#pragma unroll
            for (int i = 0; i < 8; ++i) rsv[i] = __hip_atomic_load(part_out + row0 + (i >> 2) * 128 + (i & 3) * 16, __ATOMIC_RELAXED, __HIP_MEMORY_SCOPE_AGENT);
#pragma unroll
            for (int i = 0; i < 8; ++i) rsv[i] = rsqrtf(rsv[i] * (1.f / 2048.f) + EPSV);
#pragma unroll
            for (int i = 0; i < 8; ++i) {
                const int ai = i >> 2, m = i & 3, row = row0 + ai * 128 + m * 16;
#pragma unroll
                for (int q = 0; q < 4; ++q) { const int bj = q >> 1, n = q & 1; *(f32x4*)(hb + (size_t)row * DM + col0 + bj * 128 + n * 16) = hv[ai][bj][m][n] * rsv[i] * fv[q]; }
            }
        } else if constexpr (MODE == 2) {
            float rsv[8];
#pragma unroll
            for (int i = 0; i < 8; ++i) rsv[i] = part_in[row0 + (i >> 2) * 128 + (i & 3) * 16];
#pragma unroll
            for (int i = 0; i < 8; ++i) rsv[i] = rsqrtf(rsv[i] * (1.f / 2048.f) + EPSV);
            const int col0 = u.pn * 256 + wc * 32 + 4 * fq;
#pragma unroll
            for (int ai = 0; ai < 2; ++ai)
#pragma unroll
                for (int m = 0; m < 4; ++m) {
                    const int row = row0 + ai * 128 + m * 16; const float rs = rsv[ai * 4 + m];
#pragma unroll
                    for (int bj = 0; bj < 2; ++bj)
#pragma unroll
                        for (int n = 0; n < 2; ++n) {
                            const int col = col0 + bj * 128 + n * 16;
                            if (col < UW) *(u32x2*)(outb + (size_t)row * UW + col) = pack4(acc[ai][bj][m][n] * rs);
                        }
                }
        } else {
            const int col0 = u.pn * 256 + wc * 32 + 4 * fq;
            f32x4 gbv[4];
#pragma unroll
            for (int q = 0; q < 4; ++q) gbv[q] = *(const f32x4*)(gbias + boff + col0 + (q >> 1) * 128 + (q & 1) * 16);
            u32x2 gn[4], on[4];
#pragma unroll
            for (int q = 0; q < 4; ++q) {
                gn[q] = *(const u32x2*)(U + (size_t)row0 * UW + uoff + col0 + (q >> 1) * 128 + (q & 1) * 16);
                if constexpr (MODE == 4) on[q] = *(const u32x2*)(outb + (size_t)row0 * DM + col0 + (q >> 1) * 128 + (q & 1) * 16);
            }
#pragma unroll
            for (int i = 0; i < 8; ++i) {
                const int ai = i >> 2, m = i & 3, row = row0 + ai * 128 + m * 16;
                u32x2 gc[4], oc[4];
#pragma unroll
                for (int q = 0; q < 4; ++q) { gc[q] = gn[q]; if constexpr (MODE == 4) oc[q] = on[q]; }
                if (i < 7) {
                    const int rown = row0 + ((i + 1) >> 2) * 128 + ((i + 1) & 3) * 16;
#pragma unroll
                    for (int q = 0; q < 4; ++q) {
                        gn[q] = *(const u32x2*)(U + (size_t)rown * UW + uoff + col0 + (q >> 1) * 128 + (q & 1) * 16);
                        if constexpr (MODE == 4) on[q] = *(const u32x2*)(outb + (size_t)rown * DM + col0 + (q >> 1) * 128 + (q & 1) * 16);
                    }
                }
#pragma unroll
                for (int q = 0; q < 4; ++q) {
                    const int bj = q >> 1, n = q & 1, col = col0 + bj * 128 + n * 16;
                    const u32x2 gw = gc[q]; const f32x4 gb = gbv[q];
                    f32x4 v; const f32x4 a = acc[ai][bj][m][n];
                    v[0] = sigmoidf_(bflo(gw.x) + gb[0]) * a[0]; v[1] = sigmoidf_(bfhi(gw.x) + gb[1]) * a[1];
                    v[2] = sigmoidf_(bflo(gw.y) + gb[2]) * a[2]; v[3] = sigmoidf_(bfhi(gw.y) + gb[3]) * a[3];
                    if constexpr (MODE == 4) { const u32x2 o = oc[q]; v[0] += bflo(o.x); v[1] += bfhi(o.x); v[2] += bflo(o.y); v[3] += bfhi(o.y); }
                    *(u32x2*)(outb + (size_t)row * DM + col) = pack4(v);
                }
            }
        }
    }
};

template <int MODE> __device__ __forceinline__ void run_gemm(PG8_LAS unsigned char* lds, const bf16_t* A, const bf16_t* Bt, int M, int N, int K, const Epi<MODE>& E) {
    pg8::Gemm g; g.A = A; g.Bt = Bt; g.M = M; g.N = N; g.K = K;
    pg8::StaticOrder S; S.init(M, N, (int)gridDim.x, (int)blockIdx.x);
    pg8::gemm_phase<Epi<MODE>, pg8::StaticOrder, false>(lds, g, S, E, nullptr);
}


__device__ __forceinline__ void skinny_acc(const bf16_t* A, int lda, const bf16_t* Bt, int K, int n0, int w, int fr, int fq, f32x4 (&acc)[4]) {
    const int ks = K >> 3, kbeg = w * ks;
    const bf16_t* bp = Bt + (size_t)(n0 + fr) * K + kbeg + 8 * fq;
    const bf16_t* ap = A + (size_t)fr * lda + kbeg + 8 * fq;
#pragma unroll 4
    for (int k0 = 0; k0 < ks; k0 += 32) {
        const bf16x8 bv = *(const bf16x8*)(bp + k0);
#pragma unroll
        for (int mt = 0; mt < 4; ++mt) { const bf16x8 av = *(const bf16x8*)(ap + (size_t)(16 * mt) * lda + k0); acc[mt] = mfma16(bv, av, acc[mt]); }
    }
}
template <int MODE> __device__ __forceinline__ void skinny_phase(unsigned char* smem, const bf16_t* A1, int lda1, const bf16_t* B1, int K, const bf16_t* A2, const bf16_t* B2,
                                                             bf16_t* outb, float* hx, float* partx, const float* gvec, float scale, const bf16_t* U, const float* gbias, unsigned* cnt = nullptr, const float* fnorm = nullptr, float* ys = nullptr) {
    const int tid = threadIdx.x, lane = tid & 63, w = tid >> 6, fr = lane & 15, fq = lane >> 4;
    f32x4* red = (f32x4*)smem;
    for (int c = blockIdx.x; c < 128; c += gridDim.x) {
        const int n0 = 16 * c;
        f32x4 acc[4] = {(f32x4){0.f, 0.f, 0.f, 0.f}, (f32x4){0.f, 0.f, 0.f, 0.f}, (f32x4){0.f, 0.f, 0.f, 0.f}, (f32x4){0.f, 0.f, 0.f, 0.f}};
        skinny_acc(A1, lda1, B1, K, n0, w, fr, fq, acc);
        __syncthreads();
#pragma unroll
        for (int mt = 0; mt < 4; ++mt) red[(w * 4 + mt) * 64 + lane] = acc[mt];
        if constexpr (MODE == 34) {
            f32x4 acc2[4] = {(f32x4){0.f, 0.f, 0.f, 0.f}, (f32x4){0.f, 0.f, 0.f, 0.f}, (f32x4){0.f, 0.f, 0.f, 0.f}, (f32x4){0.f, 0.f, 0.f, 0.f}};
            skinny_acc(A2, lda1, B2, K, n0, w, fr, fq, acc2);
#pragma unroll
            for (int mt = 0; mt < 4; ++mt) red[((8 + w) * 4 + mt) * 64 + lane] = acc2[mt];
        }
        __syncthreads();
        if (tid < 256) {
            const int mt = w, rl = 16 * mt + fr, row = NPR + rl, col = n0 + 4 * fq;
            f32x4 v = red[mt * 64 + lane];
#pragma unroll
            for (int ww = 1; ww < 8; ++ww) v += red[(ww * 4 + mt) * 64 + lane];
            if constexpr (MODE == 1 || MODE == 15) {
                float* hp = hx + (size_t)rl * DM + col;
                const f32x4 hv = *(const f32x4*)hp + v * scale;
                *(f32x4*)hp = hv;
                if (gvec) {
                    const f32x4 g = *(const f32x4*)(gvec + col);
                    float ss = (hv[0] * hv[0] + hv[1] * hv[1]) + (hv[2] * hv[2] + hv[3] * hv[3]);
                    *(u32x2*)(outb + (size_t)row * DM + col) = pack4(hv * g);
                    ss += __shfl_xor(ss, 16); ss += __shfl_xor(ss, 32);
                    if (fq == 0) unsafeAtomicAdd(partx + row, ss);
                }
                if constexpr (MODE == 15) {
                    float ss = (hv[0] * hv[0] + hv[1] * hv[1]) + (hv[2] * hv[2] + hv[3] * hv[3]);
                    ss += __shfl_xor(ss, 16); ss += __shfl_xor(ss, 32);
                    if (fq == 0) unsafeAtomicAdd(partx + row, ss);
                }
            } else {
                f32x4 v2 = red[(8 * 4 + mt) * 64 + lane];
#pragma unroll
                for (int ww = 1; ww < 8; ++ww) v2 += red[((8 + ww) * 4 + mt) * 64 + lane];
                const u32x2 ga = *(const u32x2*)(U + (size_t)row * UW + U_GA + col), gb = *(const u32x2*)(U + (size_t)row * UW + U_GB + col);
                const f32x4 ba = *(const f32x4*)(gbias + col), bb = *(const f32x4*)(gbias + DM + col);
                f32x4 m;
                m[0] = sigmoidf_(bflo(ga.x) + ba[0]) * v[0] + sigmoidf_(bflo(gb.x) + bb[0]) * v2[0];
                m[1] = sigmoidf_(bfhi(ga.x) + ba[1]) * v[1] + sigmoidf_(bfhi(gb.x) + bb[1]) * v2[1];
                m[2] = sigmoidf_(bflo(ga.y) + ba[2]) * v[2] + sigmoidf_(bflo(gb.y) + bb[2]) * v2[2];
                m[3] = sigmoidf_(bfhi(ga.y) + ba[3]) * v[3] + sigmoidf_(bfhi(gb.y) + bb[3]) * v2[3];
                *(u32x2*)(outb + (size_t)row * DM + col) = pack4(m);
            }
        }
    }
    if constexpr (MODE == 15) {
        const int nblk = gridDim.x < 128 ? (int)gridDim.x : 128;
        if ((int)blockIdx.x < nblk) {
            asm volatile("s_waitcnt vmcnt(0)" ::: "memory");
            __syncthreads();
            volatile unsigned& last_flag = *(volatile unsigned*)(smem + 131072 + 8);
            if (tid == 0) {
                __builtin_amdgcn_fence(__ATOMIC_RELEASE, "agent");
                asm volatile("s_waitcnt vmcnt(0)" ::: "memory");
                const unsigned old = __hip_atomic_fetch_add(cnt, 1u, __ATOMIC_RELAXED, __HIP_MEMORY_SCOPE_AGENT);
                last_flag = (old + 1u == (unsigned)nblk) ? 1u : 0u;
                if (last_flag) { __builtin_amdgcn_fence(__ATOMIC_ACQUIRE, "agent"); asm volatile("s_waitcnt vmcnt(0)" ::: "memory"); }
            }
            __syncthreads();
            if (last_flag) {
                for (int r = w; r < 32; r += 8) {
                    const float* src = hx + (size_t)(R_SAMP - NPR + r) * DM; float* dst = ys + (size_t)r * DM;
                    const float ssq = __hip_atomic_load(partx + R_SAMP + r, __ATOMIC_RELAXED, __HIP_MEMORY_SCOPE_AGENT);
                    const float rs = rsqrtf(ssq * (1.f / 2048.f) + EPSV);
#pragma unroll
                    for (int j = 0; j < 8; ++j) {
                        f32x4 v;
                        v[0] = __hip_atomic_load(src + 4 * (lane + 64 * j) + 0, __ATOMIC_RELAXED, __HIP_MEMORY_SCOPE_AGENT); v[1] = __hip_atomic_load(src + 4 * (lane + 64 * j) + 1, __ATOMIC_RELAXED, __HIP_MEMORY_SCOPE_AGENT);
                        v[2] = __hip_atomic_load(src + 4 * (lane + 64 * j) + 2, __ATOMIC_RELAXED, __HIP_MEMORY_SCOPE_AGENT); v[3] = __hip_atomic_load(src + 4 * (lane + 64 * j) + 3, __ATOMIC_RELAXED, __HIP_MEMORY_SCOPE_AGENT);
                        ((f32x4*)dst)[lane + 64 * j] = v * rs * ((const f32x4*)fnorm)[lane + 64 * j];
                    }
                }
            }
        }
    }
    __syncthreads();
}

__device__ __forceinline__ int srccol_rt(int kind, int np) {
    if (kind == 0) return np;
    if (kind == 1) { const int g = np >> 5, n = (np >> 4) & 1, i = np & 15; return n * FF + 16 * g + i; }
    if (np < 3072) return np; if (np < 8704) return np + 16; if (np < 8720) return 3072 + (np - 8704); return -1;
}
struct TrDesc { const float* W; bf16_t* WT; int K, N, nnb, kind, idx; };
constexpr int IT_PRE_END = 2528, IT_1OUT_END = 3232, IT_MIX_END = 3744, IT_2IN_SPLIT = 4096, IT_2IN_END = 5152, IT_END = 5856;
__device__ __forceinline__ bool tr_decode(const Params& p, int it, int hi, TrDesc& d) {
    if (it >= hi) return false;
    unsigned char* ws = p.ws; int r = it;
    if (r < 1408) { d = TrDesc{p.in[9], (bf16_t*)(ws + WS_BT1IN), 2048, 11264, 44, 1, r}; return true; } r -= 1408;
    if (r < 1120) { d = TrDesc{p.in[12], (bf16_t*)(ws + WS_BTIN), 2048, 8720, 35, 2, r}; return true; } r -= 1120;
    if (r < 704) { d = TrDesc{p.in[10], (bf16_t*)(ws + WS_BT1OUT), 5632, 2048, 8, 0, r}; return true; } r -= 704;
    if (r < 128) { d = TrDesc{p.in[16], (bf16_t*)(ws + WS_BTGO), 1024, 2048, 8, 0, r}; return true; } r -= 128;
    if (r < 128) { d = TrDesc{p.in[18], (bf16_t*)(ws + WS_BTSO), 1024, 2048, 8, 0, r}; return true; } r -= 128;
    if (r < 256) { d = TrDesc{p.in[20], (bf16_t*)(ws + WS_BTOUT), 2048, 2048, 8, 0, r}; return true; } r -= 256;
    if (r < 1408) { d = TrDesc{p.in[22], (bf16_t*)(ws + WS_BT2IN), 2048, 11264, 44, 1, r}; return true; } r -= 1408;
    if (r < 704) { d = TrDesc{p.in[23], (bf16_t*)(ws + WS_BT2OUT), 5632, 2048, 8, 0, r}; return true; }
    return false;
}
__device__ __forceinline__ void tr_load(const TrDesc& d, int tid, f32x4 (&v)[8]) {
    const int kb = d.idx / d.nnb, nb = d.idx - kb * d.nnb, col4 = tid & 63, krow = tid >> 6;
    const int c = srccol_rt(d.kind, nb * 256 + 4 * col4);
    const float* src = d.W + (size_t)(kb * 64 + krow) * d.N + (c >= 0 ? c : 0);
#pragma unroll
    for (int i = 0; i < 8; ++i) v[i] = (c >= 0) ? *(const f32x4*)(src + (size_t)(8 * i) * d.N) : (f32x4){0.f, 0.f, 0.f, 0.f};
}
__device__ __forceinline__ void convert_items(const Params& p, unsigned char* smem, int lo, int hi, int first, int stride) {
    const int tid = threadIdx.x;
    float* tile = (float*)smem;
    int it = lo + first; TrDesc d; bool has = tr_decode(p, it, hi, d); f32x4 v[8];
    if (has) tr_load(d, tid, v);
    const int col4 = tid & 63, krow = tid >> 6, c8 = tid & 7;
    __syncthreads();
    while (has) {
#pragma unroll
        for (int i = 0; i < 8; ++i) { const int kk = krow + 8 * i; *(f32x4*)(tile + kk * 256 + 4 * (col4 ^ ((kk >> 3) & 7))) = v[i]; }
        TrDesc dn; const bool hn = tr_decode(p, it + stride, hi, dn);
        __syncthreads();
        if (hn) tr_load(dn, tid, v);
        const int kb = d.idx / d.nnb, nb = d.idx - kb * d.nnb;
#pragma unroll
        for (int j = 0; j < 4; ++j) {
            const int n = (tid >> 3) + 64 * j; const float* s = tile + (8 * c8) * 256 + 4 * ((n >> 2) ^ c8) + (n & 3);
            u32x4 o; o.x = cvt_pk_bf16(s[0 * 256], s[1 * 256]); o.y = cvt_pk_bf16(s[2 * 256], s[3 * 256]); o.z = cvt_pk_bf16(s[4 * 256], s[5 * 256]); o.w = cvt_pk_bf16(s[6 * 256], s[7 * 256]);
            *(u32x4*)(d.WT + (size_t)(nb * 256 + n) * d.K + kb * 64 + 8 * c8) = o;
        }
        __syncthreads();
        d = dn; has = hn; it += stride;
    }
}
__device__ __forceinline__ void convert_in_tail(const Params& p, unsigned char* smem, int nunits, int lo, int hi) {
    const int G = gridDim.x, extra = nunits % G, bid = blockIdx.x;
    if (extra == 0) convert_items(p, smem, lo, hi, bid, G);
    else if (bid >= extra) convert_items(p, smem, lo, hi, bid - extra, G - extra);
}
__device__ __forceinline__ void phase_pre(const Params& p, unsigned char* smem) {
    const int tid = threadIdx.x, lane = tid & 63, wave = tid >> 6, G = gridDim.x;
    convert_items(p, smem, 0, IT_PRE_END, blockIdx.x, G);
    const int gw = blockIdx.x * 8 + wave, NGW = G * 8;
    unsigned char* ws = p.ws;
    const float* g1 = p.in[8];
    bf16_t* A = (bf16_t*)(ws + WS_A); float* part = (float*)(ws + WS_PART); float* hx = (float*)(ws + WS_HX);
    for (int r = gw; r < RT; r += NGW) {
        const float* src = r < NPR ? p.in[0] + (size_t)r * DM : r < R_SAMP ? p.in[7] + (size_t)(r - R_META) * DM : r < R_SAMP + 32 ? p.in[1] + (size_t)(r - R_SAMP) * DM : nullptr;
        f32x4 v[8]; float s = 0.f;
#pragma unroll
        for (int j = 0; j < 8; ++j) { v[j] = src ? ((const f32x4*)src)[lane + 64 * j] : (f32x4){0.f, 0.f, 0.f, 0.f}; s += (v[j][0] * v[j][0] + v[j][1] * v[j][1]) + (v[j][2] * v[j][2] + v[j][3] * v[j][3]); }
        const float tot = wave_sum(s);
#pragma unroll
        for (int j = 0; j < 8; ++j) { if (r >= NPR) ((f32x4*)(hx + (size_t)(r - NPR) * DM))[lane + 64 * j] = v[j]; const f32x4 g = ((const f32x4*)g1)[lane + 64 * j];
            *(u32x2*)(A + (size_t)r * DM + 4 * (lane + 64 * j)) = pack4(v[j] * g); }
        if (lane < 4) part[(size_t)lane * RT + r] = (lane == 0) ? tot : 0.f;
    }
}

__device__ __forceinline__ void gla_prep_item(const Params& p, unsigned char* smem, int item) {
    const int tid = threadIdx.x, lane = tid & 63, w = tid >> 6, fr = lane & 15, fq = lane >> 4;
    const int b = item >> 7, h = (item >> 5) & 3, c = item & 31, row0 = b * 2048 + 64 * c;
    float* Bc = (float*)smem;
    bf16_t* Qt = (bf16_t*)(smem + 32768);
    bf16_t* Kt = Qt + 64 * 136;
    float* GAD = (float*)(Kt + 64 * 136);
    float* TOT = GAD + 64 * 16;
    const bf16_t* U = (const bf16_t*)(p.ws + WS_UH);
    bf16_t* QTw = (bf16_t*)(p.ws + WS_QT) + (size_t)item * 8192;
    bf16_t* KHw = (bf16_t*)(p.ws + WS_KH) + (size_t)item * 8192;
    bf16_t* ATw = (bf16_t*)(p.ws + WS_ATT) + (size_t)item * 4096;
    float* DECw = (float*)(p.ws + WS_DEC) + (size_t)item * 128;
    const int d1 = tid & 127, tg = tid >> 7, t8 = tid >> 3, p8 = tid & 7;
    {
        const bf16_t* vs = U + (size_t)(row0 + t8) * UW + U_GV + h * 256 + p8 * 32;
        bf16_t* vd = (bf16_t*)(p.ws + WS_VC) + (size_t)item * 16384 + t8 * 256 + p8 * 32;
        const u32x4 v0 = *(const u32x4*)vs, v1 = *(const u32x4*)(vs + 8), v2 = *(const u32x4*)(vs + 16), v3 = *(const u32x4*)(vs + 24);
        *(u32x4*)vd = v0; *(u32x4*)(vd + 8) = v1; *(u32x4*)(vd + 16) = v2; *(u32x4*)(vd + 24) = v3;
    }
    float aup[16];
#pragma unroll
    for (int r = 0; r < 16; ++r) aup[r] = p.in[13][r * 512 + h * 128 + d1];
    const float bias1 = p.in[14][h * 128 + d1];
    __syncthreads();
    {
        const unsigned gw = *(const unsigned*)(U + (size_t)(row0 + t8) * UW + U_GAD + 2 * p8);
        GAD[t8 * 16 + 2 * p8] = bflo(gw); GAD[t8 * 16 + 2 * p8 + 1] = bfhi(gw);
    }
    float kc[16];
#pragma unroll
    for (int i = 0; i < 16; ++i) kc[i] = bf2f(U[(size_t)(row0 + tg * 16 + i) * UW + U_GK + h * 128 + d1]);
    __syncthreads();
    float bl[16]; float run = 0.f;
#pragma unroll
    for (int i = 0; i < 16; ++i) { const int t = tg * 16 + i; float x = bias1;
#pragma unroll
        for (int r = 0; r < 16; ++r) x += GAD[t * 16 + r] * aup[r];
        run += logsigf_(x) * (1.f / 16.f); bl[i] = run; }
    TOT[tg * 128 + d1] = run;
    __syncthreads();
    {
        float pre = 0.f, blast = 0.f;
#pragma unroll
        for (int g = 0; g < 4; ++g) { const float tv = TOT[g * 128 + d1]; blast += tv; if (g < tg) pre += tv; }
        float kh[16];
#pragma unroll
        for (int i = 0; i < 16; ++i) { bl[i] += pre; Bc[(tg * 16 + i) * 128 + d1] = bl[i]; kh[i] = kc[i] * __expf(blast - bl[i]); }
        u32x4 o0, o1;
        o0.x = cvt_pk_bf16(kh[0], kh[1]); o0.y = cvt_pk_bf16(kh[2], kh[3]); o0.z = cvt_pk_bf16(kh[4], kh[5]); o0.w = cvt_pk_bf16(kh[6], kh[7]);
        o1.x = cvt_pk_bf16(kh[8], kh[9]); o1.y = cvt_pk_bf16(kh[10], kh[11]); o1.z = cvt_pk_bf16(kh[12], kh[13]); o1.w = cvt_pk_bf16(kh[14], kh[15]);
        *(u32x4*)(KHw + d1 * 64 + tg * 16) = o0; *(u32x4*)(KHw + d1 * 64 + tg * 16 + 8) = o1;
        if (tg == 0) DECw[d1] = __expf(blast);
    }
    __syncthreads();
    {
        const int d0 = p8 * 16; const bf16_t* ur = U + (size_t)(row0 + t8) * UW + h * 128 + d0;
        const u32x4 q0 = *(const u32x4*)(ur + U_GQ), q1 = *(const u32x4*)(ur + U_GQ + 8), k0 = *(const u32x4*)(ur + U_GK), k1 = *(const u32x4*)(ur + U_GK + 8);
        const unsigned qw[8] = {q0.x, q0.y, q0.z, q0.w, q1.x, q1.y, q1.z, q1.w}, kw[8] = {k0.x, k0.y, k0.z, k0.w, k1.x, k1.y, k1.z, k1.w};
        unsigned qo[8], ko[8];
#pragma unroll
        for (int e = 0; e < 8; ++e) {
            const float b0 = Bc[t8 * 128 + d0 + 2 * e], b1 = Bc[t8 * 128 + d0 + 2 * e + 1];
            qo[e] = cvt_pk_bf16(bflo(qw[e]) * 0.08838834764831845f * __expf(b0), bfhi(qw[e]) * 0.08838834764831845f * __expf(b1));
            ko[e] = cvt_pk_bf16(bflo(kw[e]) * __expf(-b0), bfhi(kw[e]) * __expf(-b1));
        }
        const u32x4 qa = {qo[0], qo[1], qo[2], qo[3]}, qb = {qo[4], qo[5], qo[6], qo[7]};
        *(u32x4*)(Qt + t8 * 136 + d0) = qa; *(u32x4*)(Qt + t8 * 136 + d0 + 8) = qb;
        *(u32x4*)(QTw + t8 * 128 + d0) = qa; *(u32x4*)(QTw + t8 * 128 + d0 + 8) = qb;
        *(u32x4*)(Kt + t8 * 136 + d0) = (u32x4){ko[0], ko[1], ko[2], ko[3]}; *(u32x4*)(Kt + t8 * 136 + d0 + 8) = (u32x4){ko[4], ko[5], ko[6], ko[7]};
    }
    __syncthreads();
    {
        const int tt = w >> 1;
#pragma unroll
        for (int si = 0; si < 2; ++si) {
            const int st = 2 * (w & 1) + si; f32x4 acc = {0.f, 0.f, 0.f, 0.f};
            if (st <= tt) {
#pragma unroll
                for (int kk = 0; kk < 4; ++kk) {
                    const bf16x8 a = *(const bf16x8*)(Kt + (16 * st + fr) * 136 + 8 * fq + 32 * kk);
                    const bf16x8 bq = *(const bf16x8*)(Qt + (16 * tt + fr) * 136 + 8 * fq + 32 * kk);
                    acc = mfma16(a, bq, acc);
                }
                if (st == tt) {
#pragma unroll
                    for (int r = 0; r < 4; ++r) if (4 * fq + r > fr) acc[r] = 0.f;
                }
            }
            *(u32x2*)(ATw + (16 * tt + fr) * 64 + 16 * st + 4 * fq) = pack4c(acc);
        }
    }
}

__device__ __forceinline__ void gla_scan_unit(const Params& p, unsigned char* smem, int unit) {
    const int tid = threadIdx.x, lane = tid & 63, w = tid >> 6, fr = lane & 15, fq = lane >> 4;
    const int b = unit >> 5, h = (unit >> 3) & 3, dvs = unit & 7;
    float* Bc = (float*)smem;
    bf16_t* KhT = (bf16_t*)(smem + 32768);
    bf16_t* VT = KhT + 128 * 72;
    bf16_t* ST = VT + 2 * 32 * 72;
    float* GAD = (float*)(ST + 2 * 32 * 136);
    float* TOT = GAD + 64 * 16;
    const bf16_t* U = (const bf16_t*)(p.ws + WS_UH);
    bf16_t* Og = (bf16_t*)(p.ws + WS_OG);
    const int d1 = tid & 127, tg = tid >> 7, t8 = tid >> 3, p8 = tid & 7;
    f32x4 Sacc[2] = {(f32x4){0.f, 0.f, 0.f, 0.f}, (f32x4){0.f, 0.f, 0.f, 0.f}};
    const int vcol = U_GV + h * 256 + dvs * 32 + 4 * p8;
    __syncthreads();
    {
        float aup[16];
#pragma unroll
        for (int r = 0; r < 16; ++r) aup[r] = p.in[13][r * 512 + h * 128 + d1];
        const float bias1 = p.in[14][h * 128 + d1];
        {
            const bool ok = t8 < 16; const bf16_t* ur = U + (size_t)(R_META + (ok ? t8 : 0)) * UW;
            const unsigned gw = ok ? *(const unsigned*)(ur + U_GAD + 2 * p8) : 0u;
            GAD[t8 * 16 + 2 * p8] = bflo(gw); GAD[t8 * 16 + 2 * p8 + 1] = bfhi(gw);
            const u32x2 vw = ok ? *(const u32x2*)(ur + vcol) : (u32x2){0u, 0u};
            VT[(4 * p8 + 0) * 72 + t8] = (bf16_t)(vw.x & 0xffffu); VT[(4 * p8 + 1) * 72 + t8] = (bf16_t)(vw.x >> 16);
            VT[(4 * p8 + 2) * 72 + t8] = (bf16_t)(vw.y & 0xffffu); VT[(4 * p8 + 3) * 72 + t8] = (bf16_t)(vw.y >> 16);
        }
        float kc[16];
#pragma unroll
        for (int i = 0; i < 16; ++i) kc[i] = (tg == 0) ? bf2f(U[(size_t)(R_META + i) * UW + U_GK + h * 128 + d1]) : 0.f;
        __syncthreads();
        float bl[16]; float run = 0.f;
#pragma unroll
        for (int i = 0; i < 16; ++i) { const int t = tg * 16 + i; float x = bias1;
#pragma unroll
            for (int r = 0; r < 16; ++r) x += GAD[t * 16 + r] * aup[r];
            const float lg = (tg == 0) ? logsigf_(x) * (1.f / 16.f) : 0.f; run += lg; bl[i] = run; }
        TOT[tg * 128 + d1] = run;
        __syncthreads();
        {
            float pre = 0.f, blast = 0.f;
#pragma unroll
            for (int g = 0; g < 4; ++g) { const float tv = TOT[g * 128 + d1]; blast += tv; if (g < tg) pre += tv; }
            float kh[16];
#pragma unroll
            for (int i = 0; i < 16; ++i) { bl[i] += pre; kh[i] = kc[i] * __expf(blast - bl[i]); }
            if (tg == 0) Bc[d1] = blast;
            u32x4 o0, o1;
            o0.x = cvt_pk_bf16(kh[0], kh[1]); o0.y = cvt_pk_bf16(kh[2], kh[3]); o0.z = cvt_pk_bf16(kh[4], kh[5]); o0.w = cvt_pk_bf16(kh[6], kh[7]);
            o1.x = cvt_pk_bf16(kh[8], kh[9]); o1.y = cvt_pk_bf16(kh[10], kh[11]); o1.z = cvt_pk_bf16(kh[12], kh[13]); o1.w = cvt_pk_bf16(kh[14], kh[15]);
            *(u32x4*)(KhT + d1 * 72 + tg * 16) = o0; *(u32x4*)(KhT + d1 * 72 + tg * 16 + 8) = o1;
        }
        __syncthreads();
#pragma unroll
        for (int dvt = 0; dvt < 2; ++dvt) {
            f32x4 nw = {0.f, 0.f, 0.f, 0.f};
#pragma unroll
            for (int kk = 0; kk < 2; ++kk) {
                const bf16x8 a = *(const bf16x8*)(KhT + (16 * w + fr) * 72 + 8 * fq + 32 * kk);
                const bf16x8 bb = *(const bf16x8*)(VT + (16 * dvt + fr) * 72 + 8 * fq + 32 * kk);
                nw = mfma16(a, bb, nw);
            }
            Sacc[dvt] = nw;
        }
    }
    const size_t item0 = (size_t)((b * 4 + h) * 32);
    const bf16_t* QTw = (const bf16_t*)(p.ws + WS_QT) + item0 * 8192 + (16 * (w >> 1) + fr) * 128 + 8 * fq;
    const bf16_t* ATw = (const bf16_t*)(p.ws + WS_ATT) + item0 * 4096 + (16 * (w >> 1) + fr) * 64 + 8 * fq;
    const bf16_t* KHw = (const bf16_t*)(p.ws + WS_KH) + item0 * 8192 + (16 * w + fr) * 64 + 8 * fq;
    const float* DECw = (const float*)(p.ws + WS_DEC) + item0 * 128 + 16 * w + 4 * fq;
    const bf16_t* Vg = (const bf16_t*)(p.ws + WS_VC) + item0 * 16384 + t8 * 256 + dvs * 32 + 4 * p8;
    struct Ops { bf16x8 q[4], a[2], kh[2]; f32x4 dec; u32x2 v; };
    Ops r0, r1, r2;
#define GLA_LOAD(R, cc) do { const int c_ = (cc) < 32 ? (cc) : 31; \
        _Pragma("unroll") for (int kk = 0; kk < 4; ++kk) R.q[kk] = *(const bf16x8*)(QTw + (size_t)c_ * 8192 + 32 * kk); \
        _Pragma("unroll") for (int kk = 0; kk < 2; ++kk) { R.a[kk] = *(const bf16x8*)(ATw + (size_t)c_ * 4096 + 32 * kk); R.kh[kk] = *(const bf16x8*)(KHw + (size_t)c_ * 8192 + 32 * kk); } \
        R.dec = *(const f32x4*)(DECw + c_ * 128); R.v = *(const u32x2*)(Vg + (size_t)c_ * 16384); } while (0)
    GLA_LOAD(r0, 0); GLA_LOAD(r1, 1);
    __syncthreads();
#pragma unroll
    for (int dvt = 0; dvt < 2; ++dvt) *(u32x2*)(ST + (16 * dvt + fr) * 136 + 16 * w + 4 * fq) = pack4c(Sacc[dvt]);
    VT[(4 * p8 + 0) * 72 + t8] = (bf16_t)(r0.v.x & 0xffffu); VT[(4 * p8 + 1) * 72 + t8] = (bf16_t)(r0.v.x >> 16);
    VT[(4 * p8 + 2) * 72 + t8] = (bf16_t)(r0.v.y & 0xffffu); VT[(4 * p8 + 3) * 72 + t8] = (bf16_t)(r0.v.y >> 16);
#define GLA_BODY(cc, CUR, NX1, FAR) do { const int c = (cc); \
        GLA_LOAD(FAR, c + 2); \
        asm volatile("s_waitcnt lgkmcnt(0)" ::: "memory"); __builtin_amdgcn_s_barrier(); asm volatile("" ::: "memory"); \
        const bf16_t* vt = VT + (c & 1) * (32 * 72); const bf16_t* st = ST + (c & 1) * (32 * 136); \
        { const int tt = w >> 1, dvt = w & 1; f32x4 acc = {0.f, 0.f, 0.f, 0.f}, acc2 = {0.f, 0.f, 0.f, 0.f}; \
          const bf16x8 lv0 = *(const bf16x8*)(vt + (16 * dvt + fr) * 72 + 8 * fq), lv1 = *(const bf16x8*)(vt + (16 * dvt + fr) * 72 + 8 * fq + 32); \
          const bf16x8 ls0 = *(const bf16x8*)(st + (16 * dvt + fr) * 136 + 8 * fq), ls1 = *(const bf16x8*)(st + (16 * dvt + fr) * 136 + 8 * fq + 32), \
                       ls2 = *(const bf16x8*)(st + (16 * dvt + fr) * 136 + 8 * fq + 64), ls3 = *(const bf16x8*)(st + (16 * dvt + fr) * 136 + 8 * fq + 96); \
          __builtin_amdgcn_sched_barrier(0); \
          acc = mfma16(lv0, CUR.a[0], acc); acc2 = mfma16(ls0, CUR.q[0], acc2); acc = mfma16(lv1, CUR.a[1], acc); acc2 = mfma16(ls1, CUR.q[1], acc2); \
          acc = mfma16(ls2, CUR.q[2], acc); acc2 = mfma16(ls3, CUR.q[3], acc2); acc = acc + acc2; \
          *(u32x2*)(Og + (size_t)(b * 2048 + 64 * c + 16 * tt + fr) * 1024 + h * 256 + dvs * 32 + 16 * dvt + 4 * fq) = pack4c(acc); } \
        bf16_t* stn = ST + ((c + 1) & 1) * (32 * 136); bf16_t* vtn = VT + ((c + 1) & 1) * (32 * 72); \
        _Pragma("unroll") for (int dvt = 0; dvt < 2; ++dvt) { f32x4 nw = {0.f, 0.f, 0.f, 0.f}; \
          _Pragma("unroll") for (int kk = 0; kk < 2; ++kk) nw = mfma16(CUR.kh[kk], *(const bf16x8*)(vt + (16 * dvt + fr) * 72 + 8 * fq + 32 * kk), nw); \
          Sacc[dvt] = Sacc[dvt] * CUR.dec + nw; \
          *(u32x2*)(stn + (16 * dvt + fr) * 136 + 16 * w + 4 * fq) = pack4c(Sacc[dvt]); } \
        vtn[(4 * p8 + 0) * 72 + t8] = (bf16_t)(NX1.v.x & 0xffffu); vtn[(4 * p8 + 1) * 72 + t8] = (bf16_t)(NX1.v.x >> 16); \
        vtn[(4 * p8 + 2) * 72 + t8] = (bf16_t)(NX1.v.y & 0xffffu); vtn[(4 * p8 + 3) * 72 + t8] = (bf16_t)(NX1.v.y >> 16); } while (0)
    for (int c3 = 0; c3 < 30; c3 += 3) {
        GLA_BODY(c3, r0, r1, r2);
        GLA_BODY(c3 + 1, r1, r2, r0);
        GLA_BODY(c3 + 2, r2, r0, r1);
    }
    GLA_BODY(30, r0, r1, r2);
    GLA_BODY(31, r1, r2, r0);
#undef GLA_BODY
#undef GLA_LOAD
    float* pg = p.out + O_PGLA + (size_t)((b * 4 + h) * 128) * 256 + dvs * 32;
#pragma unroll
    for (int dvt = 0; dvt < 2; ++dvt)
#pragma unroll
        for (int r = 0; r < 4; ++r) pg[(size_t)(16 * w + 4 * fq + r) * 256 + 16 * dvt + fr] = Sacc[dvt][r];
    __syncthreads();
}

__device__ __forceinline__ void swa_prompt_unit(const Params& p, unsigned char* smem, int unit) {
    const int tid = threadIdx.x, lane = tid & 63, w = tid >> 6, fr = lane & 15, fq = lane >> 4;
    const int b = unit >> 6, kvh = (unit >> 4) & 3, n = unit & 15;
    bf16_t* Ks = (bf16_t*)smem;
    bf16_t* VT = Ks + 272 * 72;
    const bf16_t* U = (const bf16_t*)(p.ws + WS_UH);
    bf16_t* O = (bf16_t*)(p.ws + WS_O);
    __syncthreads();
    {
        u32x4 kv[5], vv[5];
#pragma unroll
        for (int it = 0; it < 5; ++it) {
            const int idx = tid + 512 * it; const int sl = idx >> 3, c8 = idx & 7;
            int row; bool ok = idx < 272 * 8;
            if (sl < 16) row = R_META + sl; else { const int pos = n * 128 + (sl - 16) - 128; ok = ok && pos >= 0; row = b * 2048 + pos; }
            kv[it] = (u32x4){0u, 0u, 0u, 0u}; vv[it] = (u32x4){0u, 0u, 0u, 0u};
            if (ok) { const bf16_t* ur = U + (size_t)row * UW + kvh * 64 + 8 * c8; kv[it] = *(const u32x4*)(ur + U_SK); vv[it] = *(const u32x4*)(ur + U_SV); }
        }
#pragma unroll
        for (int it = 0; it < 5; ++it) {
            const int idx = tid + 512 * it; const int sl = idx >> 3, c8 = idx & 7;
            if (idx < 272 * 8) {
                *(u32x4*)(Ks + sl * 72 + 8 * c8) = kv[it];
                bf16_t* vt = VT + (8 * c8) * 280 + sl; const u32x4 v4 = vv[it];
                vt[0 * 280] = (bf16_t)(v4.x & 0xffffu); vt[1 * 280] = (bf16_t)(v4.x >> 16); vt[2 * 280] = (bf16_t)(v4.y & 0xffffu); vt[3 * 280] = (bf16_t)(v4.y >> 16);
                vt[4 * 280] = (bf16_t)(v4.z & 0xffffu); vt[5 * 280] = (bf16_t)(v4.z >> 16); vt[6 * 280] = (bf16_t)(v4.w & 0xffffu); vt[7 * 280] = (bf16_t)(v4.w >> 16);
            }
        }
    }
    __syncthreads();
    const int qt = w;
    bf16x8 qall[4][2];
#pragma unroll
    for (int g = 0; g < 4; ++g) { const bf16_t* qp0 = U + (size_t)(b * 2048 + n * 128 + 16 * qt + fr) * UW + U_SQ + (kvh * 4 + g) * 64 + 8 * fq; qall[g][0] = *(const bf16x8*)qp0; qall[g][1] = *(const bf16x8*)(qp0 + 32); }
#pragma unroll
    for (int g = 0; g < 4; ++g) {
        const int head = kvh * 4 + g;
        const float slope = exp2f(-0.5f * (float)(head + 1)), sink = p.in[17][head];
        const int qrow = b * 2048 + n * 128 + 16 * qt + fr;
        const bf16x8 qf0 = qall[g][0], qf1 = qall[g][1];
        f32x4 sc[10];
        float mx = -1e30f;
#pragma unroll
        for (int T = 0; T < 10; ++T) {
            const int slot0 = (T == 0) ? 0 : 16 + 16 * (qt + T - 1);
            f32x4 acc = {0.f, 0.f, 0.f, 0.f};
            acc = mfma16(*(const bf16x8*)(Ks + (slot0 + fr) * 72 + 8 * fq), qf0, acc);
            acc = mfma16(*(const bf16x8*)(Ks + (slot0 + fr) * 72 + 8 * fq + 32), qf1, acc);
#pragma unroll
            for (int r = 0; r < 4; ++r) {
                float s = acc[r] * 0.125f;
                if (T > 0) {
                    const int j = 16 * (qt + T - 1) + 4 * fq + r, i = 16 * qt + fr, dist = i + 128 - j;
                    const bool valid = (dist >= 0) && (dist < 128) && (n * 128 + j - 128 >= 0);
                    s = valid ? s - slope * (float)dist : -1e30f;
                }
                acc[r] = s; mx = fmaxf(mx, s);
            }
            sc[T] = acc;
        }
        mx = fmaxf(mx, __shfl_xor(mx, 16)); mx = fmaxf(mx, __shfl_xor(mx, 32)); mx = fmaxf(mx, sink);
        float sum = 0.f;
#pragma unroll
        for (int T = 0; T < 10; ++T)
#pragma unroll
            for (int r = 0; r < 4; ++r) { const float e = __expf(sc[T][r] - mx); sc[T][r] = e; sum += e; }
        sum += __shfl_xor(sum, 16); sum += __shfl_xor(sum, 32);
        const float inv = 1.f / (sum + __expf(sink - mx));
        f32x4 oacc[4] = {(f32x4){0.f, 0.f, 0.f, 0.f}, (f32x4){0.f, 0.f, 0.f, 0.f}, (f32x4){0.f, 0.f, 0.f, 0.f}, (f32x4){0.f, 0.f, 0.f, 0.f}};
#pragma unroll
        for (int pp = 0; pp < 5; ++pp) {
            const int T0 = 2 * pp, T1 = 2 * pp + 1;
            const int s0 = (T0 == 0) ? 0 : 16 + 16 * (qt + T0 - 1), s1 = 16 + 16 * (qt + T1 - 1);
            const u32x2 pa = pack4(sc[T0]), pb = pack4(sc[T1]);
            const u32x4 pw = {pa.x, pa.y, pb.x, pb.y};
            bf16x8 pf; __builtin_memcpy(&pf, &pw, 16);
#pragma unroll
            for (int dvt = 0; dvt < 4; ++dvt) {
                const u32x2 va = *(const u32x2*)(VT + (16 * dvt + fr) * 280 + s0 + 4 * fq), vb = *(const u32x2*)(VT + (16 * dvt + fr) * 280 + s1 + 4 * fq);
                const u32x4 vw = {va.x, va.y, vb.x, vb.y};
                bf16x8 vf; __builtin_memcpy(&vf, &vw, 16);
                oacc[dvt] = mfma16(vf, pf, oacc[dvt]);
            }
        }
#pragma unroll
        for (int dvt = 0; dvt < 4; ++dvt) *(u32x2*)(O + (size_t)qrow * 1024 + head * 64 + 16 * dvt + 4 * fq) = pack4(oacc[dvt] * inv);
    }
    __syncthreads();
}

__device__ __forceinline__ float gla_state_step(const float* __restrict__ s0p, float* __restrict__ snp, const float* eg, const float* kk, const float* qt, float v, int dbeg) {
    float op = 0.f;
#pragma unroll 8
    for (int d = dbeg; d < dbeg + 64; ++d) { const float s0 = s0p[(size_t)d * 256]; snp[(size_t)d * 256] = s0 * eg[d] + kk[d] * v; op += qt[d] * s0; }
    return op;
}
__device__ __forceinline__ void gla_sample_unit(const Params& p, unsigned char* smem, int unit) {
    const int tid = threadIdx.x; const int i = unit >> 2, h = unit & 3, row = R_SAMP + i;
    float* eg = (float*)smem; float* qt = eg + 128; float* kk = qt + 128; float* vv = kk + 128; float* red = vv + 256; float* red2 = red + 128;
    const bf16_t* ur = (const bf16_t*)(p.ws + WS_UH) + (size_t)row * UW;
    bf16_t* Og = (bf16_t*)(p.ws + WS_OG);
    __syncthreads();
    if (tid < 128) {
        const int d = tid; float x = p.in[14][h * 128 + d];
#pragma unroll
        for (int r = 0; r < 16; ++r) x += bf2f(ur[U_GAD + r]) * p.in[13][r * 512 + h * 128 + d];
        const float lg = logsigf_(x) * (1.f / 16.f), e = __expf(lg);
        const float q = bf2f(ur[U_GQ + h * 128 + d]) * 0.08838834764831845f, k = bf2f(ur[U_GK + h * 128 + d]);
        eg[d] = e; qt[d] = q * e; kk[d] = k; red[d] = q * k;
    } else if (tid < 384) { const int dv = tid - 128; vv[dv] = bf2f(ur[U_GV + h * 256 + dv]); }
    __syncthreads();
    float qk = 0.f;
    for (int d = 0; d < 128; ++d) qk += red[d];
    const int dv = tid & 255, half = tid >> 8;
    const float* s0p = p.in[6] + (size_t)((i * 4 + h) * 128) * 256 + dv;
    float* snp = p.out + O_SGLA + (size_t)((i * 4 + h) * 128) * 256 + dv;
    const float v = vv[dv]; const float op = gla_state_step(s0p, snp, eg, kk, qt, v, half * 64);
    red2[tid] = op;
    __syncthreads();
    if (half == 0) { const float o = red2[tid] + red2[tid + 256] + qk * v; Og[(size_t)row * 1024 + h * 256 + dv] = f2bf(o); }
    __syncthreads();
}

__device__ __forceinline__ void swa_sample_unit(const Params& p, unsigned char* smem, int unit) {
    const int tid = threadIdx.x, lane = tid & 63, w = tid >> 6; const int i = unit >> 2, kvh = unit & 3, row = R_SAMP + i;
    float* qv = (float*)smem; float* knew = qv + 256; float* vnew = knew + 64; float* sc = vnew + 64; float* invd = sc + 4 * 144; float* red2 = invd + 4;
    const bf16_t* ur = (const bf16_t*)(p.ws + WS_UH) + (size_t)row * UW;
    bf16_t* O = (bf16_t*)(p.ws + WS_O);
    const float* cmk = p.in[2]; const float* cmv = p.in[3]; const float* cwk = p.in[4]; const float* cwv = p.in[5];
    __syncthreads();
    if (tid < 256) qv[tid] = bf2f(ur[U_SQ + kvh * 256 + tid]) * 0.125f;
    else if (tid < 320) knew[tid - 256] = bf2f(ur[U_SK + kvh * 64 + (tid - 256)]);
    else if (tid < 384) vnew[tid - 320] = bf2f(ur[U_SV + kvh * 64 + (tid - 320)]);
    __syncthreads();
    for (int idx = tid; idx < 576; idx += 512) {
        const int g = idx / 144, key = idx % 144; const float slope = exp2f(-0.5f * (float)(kvh * 4 + g + 1));
        float s = 0.f, biasv = 0.f;
        if (key == 143) { for (int c = 0; c < 64; ++c) s += qv[g * 64 + c] * knew[c]; }
        else {
            const float* kp;
            if (key < 16) kp = cmk + (size_t)((i * 16 + key) * 4 + kvh) * 64;
            else { const int c = key - 15; kp = cwk + (size_t)((i * 128 + c) * 4 + kvh) * 64; biasv = slope * (float)(128 - c); }
#pragma unroll 4
            for (int c4 = 0; c4 < 16; ++c4) { const f32x4 kvv = ((const f32x4*)kp)[c4]; const float* q4 = qv + g * 64 + 4 * c4;
                s += (q4[0] * kvv[0] + q4[1] * kvv[1]) + (q4[2] * kvv[2] + q4[3] * kvv[3]); }
        }
        sc[g * 144 + key] = s - biasv;
    }
    __syncthreads();
    if (w < 4) {
        const int g = w; const float sink = p.in[17][kvh * 4 + g];
        float m = -1e30f;
        for (int key = lane; key < 144; key += 64) m = fmaxf(m, sc[g * 144 + key]);
        m = fmaxf(wave_max(m), sink);
        float sum = 0.f;
        for (int key = lane; key < 144; key += 64) { const float e = __expf(sc[g * 144 + key] - m); sc[g * 144 + key] = e; sum += e; }
        sum = wave_sum(sum);
        if (lane == 0) invd[g] = 1.f / (sum + __expf(sink - m));
    }
    __syncthreads();
    {
        const int g = (tid >> 6) & 3, dv = tid & 63, half = tid >> 8; float op = 0.f;
        const float* scg = sc + g * 144;
        if (half == 0) {
            const float* mv = cmv + (size_t)(i * 16 * 4 + kvh) * 64 + dv;
#pragma unroll
            for (int key = 0; key < 16; ++key) op += scg[key] * mv[(size_t)key * 256];
            const float* wv = cwv + (size_t)((i * 128 + 1) * 4 + kvh) * 64 + dv;
#pragma unroll 8
            for (int c = 0; c < 56; ++c) op += scg[16 + c] * wv[(size_t)c * 256];
        } else {
            const float* wv = cwv + (size_t)((i * 128 + 57) * 4 + kvh) * 64 + dv;
#pragma unroll 8
            for (int c = 0; c < 71; ++c) op += scg[72 + c] * wv[(size_t)c * 256];
            op += scg[143] * vnew[dv];
        }
        red2[tid] = op;
    }
    __syncthreads();
    if (tid < 256) { const int g = tid >> 6, dv = tid & 63; O[(size_t)row * 1024 + (kvh * 4 + g) * 64 + dv] = f2bf((red2[tid] + red2[tid + 256]) * invd[g]); }
    float* owk = p.out + O_SWK; float* owv = p.out + O_SWV;
    for (int ib = 0; ib < 16; ib += 8) {
        float kb[8], vb[8];
#pragma unroll
        for (int it = 0; it < 8; ++it) {
            const int idx = tid + 512 * (ib + it), c = idx >> 6, e = idx & 63;
            if (c < 127) { const size_t si = (size_t)((i * 128 + c + 1) * 4 + kvh) * 64 + e; kb[it] = cwk[si]; vb[it] = cwv[si]; }
            else { kb[it] = knew[e]; vb[it] = vnew[e]; }
        }
#pragma unroll
        for (int it = 0; it < 8; ++it) {
            const int idx = tid + 512 * (ib + it), c = idx >> 6, e = idx & 63; const size_t di = (size_t)((i * 128 + c) * 4 + kvh) * 64 + e;
            owk[di] = kb[it]; owv[di] = vb[it];
        }
    }
    __syncthreads();
}

__device__ __forceinline__ void phase_mixer_a(const Params& p, unsigned char* smem) {
    const int G = gridDim.x, bid = blockIdx.x;
    for (int u = bid; u < 512; u += G) gla_prep_item(p, smem, u);
}
__device__ __forceinline__ void phase_mixer_b(const Params& p, unsigned char* smem) {
    const int G = gridDim.x, bid = blockIdx.x;
    for (int u = bid; u < 128; u += G) gla_scan_unit(p, smem, ((u & 7) << 4) | (u >> 3));
    const bool split = G >= 256;
    if (split && bid < 128) return;
    const int vb = split ? bid - 128 : bid, nb = split ? G - 128 : G;
    for (int u = vb; u < 256; u += nb) swa_prompt_unit(p, smem, u);
    for (int u = vb; u < 128; u += nb) gla_sample_unit(p, smem, u);
    for (int u = vb; u < 128; u += nb) swa_sample_unit(p, smem, u);
}

__device__ __forceinline__ void phase_gnorm(const Params& p) {
    const int tid = threadIdx.x, lane = tid & 63, wave = tid >> 6;
    const int gw = blockIdx.x * 8 + wave, NGW = gridDim.x * 8;
    const bf16_t* U = (const bf16_t*)(p.ws + WS_UH); bf16_t* Og = (bf16_t*)(p.ws + WS_OG); const float* onorm = p.in[15];
    for (int ri = gw; ri < NPR + 32; ri += NGW) {
        const int row = ri < NPR ? ri : R_SAMP + (ri - NPR);
#pragma unroll
        for (int hh = 0; hh < 4; ++hh) {
            const int col = hh * 256 + 4 * lane;
            u32x2* op = (u32x2*)(Og + (size_t)row * 1024 + col);
            const u32x2 ow = *op; const u32x2 gw2 = *(const u32x2*)(U + (size_t)row * UW + U_GR + col);
            const f32x4 on = *(const f32x4*)(onorm + col);
            const float o0 = bflo(ow.x), o1 = bfhi(ow.x), o2 = bflo(ow.y), o3 = bfhi(ow.y);
            const float ss = wave_sum((o0 * o0 + o1 * o1) + (o2 * o2 + o3 * o3));
            const float rs = rsqrtf(ss * (1.f / 256.f) + EPSV);
            f32x4 v; v[0] = o0 * rs * on[0] * siluf_(bflo(gw2.x)); v[1] = o1 * rs * on[1] * siluf_(bfhi(gw2.x));
            v[2] = o2 * rs * on[2] * siluf_(bflo(gw2.y)); v[3] = o3 * rs * on[3] * siluf_(bfhi(gw2.y));
            *op = pack4(v);
        }
    }
    const int gt = blockIdx.x * 512 + tid, NT = gridDim.x * 512;
    for (int idx = gt; idx < 2 * 16384 + 2 * 131072; idx += NT) {
        if (idx < 32768) { const int which = idx >> 14, r = idx & 16383, m = (r >> 8) & 15, col = r & 255;
            p.out[(which ? O_PMV : O_PMK) + r] = bf2f(U[(size_t)(R_META + m) * UW + (which ? U_SV : U_SK) + col]); }
        else { const int r2 = idx - 32768, which = r2 >> 17, r = r2 & 131071, b = r >> 15, j = (r >> 8) & 127, col = r & 255;
            p.out[(which ? O_PWV : O_PWK) + r] = bf2f(U[(size_t)(b * 2048 + 1920 + j) * UW + (which ? U_SV : U_SK) + col]); }
    }
}

__device__ __forceinline__ void phase_final(const Params& p) {
    const int tid = threadIdx.x, lane = tid & 63, wave = tid >> 6;
    const int gw = blockIdx.x * 8 + wave, NGW = gridDim.x * 8;
    const float* fn = p.in[24]; const float* hx = (const float*)(p.ws + WS_HX);
    for (int ri = gw; ri < NPR + 32; ri += NGW) {
        const float* src = ri < NPR ? p.out + O_YP + (size_t)ri * DM : hx + (size_t)(R_SAMP - NPR + (ri - NPR)) * DM;
        float* dst = ri < NPR ? p.out + O_YP + (size_t)ri * DM : p.out + O_YS + (size_t)(ri - NPR) * DM;
        f32x4 v[8]; float s = 0.f;
#pragma unroll
        for (int j = 0; j < 8; ++j) { v[j] = ((const f32x4*)src)[lane + 64 * j]; s += (v[j][0] * v[j][0] + v[j][1] * v[j][1]) + (v[j][2] * v[j][2] + v[j][3] * v[j][3]); }
        const float rs = rsqrtf(wave_sum(s) * (1.f / 2048.f) + EPSV);
#pragma unroll
        for (int j = 0; j < 8; ++j) ((f32x4*)dst)[lane + 64 * j] = v[j] * rs * ((const f32x4*)fn)[lane + 64 * j];
    }
}

typedef const __attribute__((address_space(4))) Params* KParams;
__global__ void __launch_bounds__(512, 2) mega_fwd(Params p_arg) {
    extern __shared__ __attribute__((aligned(16))) unsigned char smem[];
    cg::grid_group grid = cg::this_grid();
    const int ph_lo = p_arg.ph_lo, ph_hi = p_arg.ph_hi;
    volatile LAS unsigned* xst = (volatile LAS unsigned*)((PG8_LAS unsigned char*)smem + 131072);
    if (threadIdx.x == 0) { xst[0] = 0u; xst[1] = 0u; }
    __syncthreads();
    const XcdBarrier xb = xcd_barrier_post((unsigned*)(p_arg.ws + WS_BAR), xst);
#ifndef REP_MASK
#define REP_MASK 0x000
#endif
#ifndef PHMASK
#define PHMASK 0xfff
#endif
#define PHASE(n, ...) if constexpr ((PHMASK >> (n)) & 1) if (ph_lo <= (n) && (n) < ph_hi) { if ((n) > ph_lo) xcd_barrier(xb); \
        KParams kp = (KParams)__builtin_amdgcn_kernarg_segment_ptr(); asm volatile("" : "+s"(kp) :: "memory"); const Params& p = *(const Params*)kp; \
        PG8_LAS unsigned char* lds = (PG8_LAS unsigned char*)smem; unsigned char* ws = p.ws; (void)lds; (void)ws; \
        bf16_t* Abuf = (bf16_t*)(ws + WS_A); bf16_t* UH = (bf16_t*)(ws + WS_UH); bf16_t* Og = (bf16_t*)(ws + WS_OG); bf16_t* Ob = (bf16_t*)(ws + WS_O); \
        float* part = (float*)(ws + WS_PART); float* hx = (float*)(ws + WS_HX); float* partx = (float*)(ws + WS_PARTX); float* hmain = p.out + O_YP; (void)partx; (void)Abuf; (void)UH; (void)Og; (void)Ob; (void)part; (void)hx; (void)hmain; \
        { __VA_ARGS__ } if constexpr ((REP_MASK >> (n)) & 1) { asm volatile("" ::: "memory"); __VA_ARGS__ } }
    PHASE(0, phase_pre(p, smem);)
    PHASE(1, Epi<0> E{}; E.outb = UH; E.part_in = part; run_gemm<0>(lds, Abuf, (const bf16_t*)(ws + WS_BT1IN), RT, 11264, 2048, E);
             convert_in_tail(p, smem, 33 * 44, IT_PRE_END, IT_1OUT_END); convert_in_tail(p, smem, 33 * 44, IT_MIX_END, IT_2IN_SPLIT);)
#ifdef EXP_G2
    PHASE(2, Epi<1> E{}; E.outb = Abuf; E.hmain = hmain; E.hx = hx; E.part_out = part + RT; E.gvec = nullptr; E.scale = 0.25f; run_gemm<1>(lds, UH, (const bf16_t*)(ws + WS_BT1OUT), NPR, 2048, 5632, E);
             E.gvec = p.in[11]; run_gemm<1>(lds, UH, (const bf16_t*)(ws + WS_BT1OUT), NPR, 2048, 5632, E);
             skinny_phase<1>(smem, UH + (size_t)NPR * FF, FF, (const bf16_t*)(ws + WS_BT1OUT), 5632, nullptr, nullptr, Abuf, hx, part + RT, p.in[11], 0.5f, nullptr, nullptr);)
#else
    PHASE(2, Epi<1> E{}; E.outb = Abuf; E.hmain = hmain; E.hsrc = p.in[0]; E.hx = hx; E.part_out = part + RT; E.gvec = p.in[11]; E.scale = 0.5f; run_gemm<1>(lds, UH, (const bf16_t*)(ws + WS_BT1OUT), NPR, 2048, 5632, E);
             skinny_phase<1>(smem, UH + (size_t)NPR * FF, FF, (const bf16_t*)(ws + WS_BT1OUT), 5632, nullptr, nullptr, Abuf, hx, part + RT, p.in[11], 0.5f, nullptr, nullptr);)
#endif
    PHASE(3, Epi<2> E{}; E.outb = UH; E.part_in = part + RT; run_gemm<2>(lds, Abuf, (const bf16_t*)(ws + WS_BTIN), RT, NIN_PAD, 2048, E);
             convert_in_tail(p, smem, 33 * 35, IT_1OUT_END, IT_MIX_END); convert_in_tail(p, smem, 33 * 35, IT_2IN_SPLIT, IT_2IN_END);)
    PHASE(4, phase_mixer_a(p, smem);)
    PHASE(5, phase_mixer_b(p, smem);)
    PHASE(6, phase_gnorm(p);)
    PHASE(7, Epi<3> E3{}; E3.outb = Abuf; E3.U = UH; E3.gbias = p.in[19]; E3.uoff = U_GA; E3.boff = 0; run_gemm<3>(lds, Og, (const bf16_t*)(ws + WS_BTGO), NPR, 2048, 1024, E3);
             Epi<4> E4{}; E4.outb = Abuf; E4.U = UH; E4.gbias = p.in[19]; E4.uoff = U_GB; E4.boff = DM; run_gemm<4>(lds, Ob, (const bf16_t*)(ws + WS_BTSO), NPR, 2048, 1024, E4);
             skinny_phase<34>(smem, Og + (size_t)NPR * 1024, 1024, (const bf16_t*)(ws + WS_BTGO), 1024, Ob + (size_t)NPR * 1024, (const bf16_t*)(ws + WS_BTSO), Abuf, nullptr, nullptr, nullptr, 0.f, UH, p.in[19]);)
    PHASE(8, Epi<1> E{}; E.outb = Og; E.hmain = hmain; E.hsrc = hmain; E.hx = hx; E.part_out = part + 2 * RT; E.gvec = p.in[21]; E.scale = 1.0f; run_gemm<1>(lds, Abuf, (const bf16_t*)(ws + WS_BTOUT), NPR, 2048, 2048, E);
             skinny_phase<1>(smem, Abuf + (size_t)NPR * DM, DM, (const bf16_t*)(ws + WS_BTOUT), 2048, nullptr, nullptr, Og, hx, part + 2 * RT, p.in[21], 1.0f, nullptr, nullptr);)
    PHASE(9, Epi<0> E{}; E.outb = UH; E.part_in = part + 2 * RT; run_gemm<0>(lds, Og, (const bf16_t*)(ws + WS_BT2IN), RT, 11264, 2048, E);
             convert_in_tail(p, smem, 33 * 44, IT_2IN_END, IT_END);)
    const bool fused_final = (gridDim.x == 256);
    PHASE(10, if (fused_final) {
                 Epi<5> E{}; E.hmain = hmain; E.hsrc = hmain; E.part_out = part + 3 * RT; E.scale = 0.5f; E.cnt = (unsigned*)(ws + WS_CNT); E.fnorm = p.in[24];
                 run_gemm<5>(lds, UH, (const bf16_t*)(ws + WS_BT2OUT), NPR, 2048, 5632, E);
                 skinny_phase<15>(smem, UH + (size_t)NPR * FF, FF, (const bf16_t*)(ws + WS_BT2OUT), 5632, nullptr, nullptr, nullptr, hx, part + 3 * RT, nullptr, 0.5f, nullptr, nullptr, (unsigned*)(ws + WS_CNT) + 64 * 36, p.in[24], p.out + O_YS);
             } else {
                 Epi<1> E{}; E.outb = nullptr; E.hmain = hmain; E.hsrc = hmain; E.hx = hx; E.part_out = nullptr; E.gvec = nullptr; E.scale = 0.5f; run_gemm<1>(lds, UH, (const bf16_t*)(ws + WS_BT2OUT), NPR, 2048, 5632, E);
                 skinny_phase<1>(smem, UH + (size_t)NPR * FF, FF, (const bf16_t*)(ws + WS_BT2OUT), 5632, nullptr, nullptr, nullptr, hx, partx, nullptr, 0.5f, nullptr, nullptr);
             })
    if (!fused_final) { PHASE(11, phase_final(p);) }
#undef PHASE
}

extern "C" void kernel_launch(void* const* d_in, const int* in_sizes, int n_in, void* d_out, int out_size, void* d_ws, size_t ws_size, hipStream_t stream) {
    static int grid = 0;
    if (grid == 0) {
        if (n_in != 25 || out_size != 23953408 || ws_size < WS_END) { fprintf(stderr, "kernel_launch: unexpected shapes n_in %d out %d ws %zu (need %zu)\n", n_in, out_size, ws_size, (size_t)WS_END); grid = -1; return; }
        int dev = 0, cus = 0, per_cu = 0;
        hipGetDevice(&dev); hipDeviceGetAttribute(&cus, hipDeviceAttributeMultiprocessorCount, dev);
        if (hipFuncSetAttribute((const void*)mega_fwd, hipFuncAttributeMaxDynamicSharedMemorySize, LDS_BYTES) != hipSuccess) { fprintf(stderr, "kernel_launch: hipFuncSetAttribute failed\n"); grid = -1; return; }
        hipOccupancyMaxActiveBlocksPerMultiprocessor(&per_cu, (const void*)mega_fwd, 512, LDS_BYTES);
        if (per_cu < 1) { fprintf(stderr, "kernel_launch: occupancy query says %d blocks per CU\n", per_cu); per_cu = 1; }
        (void)hipGetLastError();
        grid = cus;
        if (grid > 256) grid = 256;
    }
    if (grid < 0) return;
    if (hipMemsetAsync((char*)d_ws + WS_BAR, 0, (size_t)(XCD_BAR_WORDS + CNT_WORDS) * 4, stream) != hipSuccess) { fprintf(stderr, "kernel_launch: memset of the barrier words failed\n"); return; }
    Params p{};
    for (int i = 0; i < 25; ++i) p.in[i] = (const float*)d_in[i];
    p.out = (float*)d_out; p.ws = (unsigned char*)d_ws;
#if MK_LAUNCHES == 1
    p.ph_lo = 0; p.ph_hi = NPHASE;
    void* args[] = {&p};
    hipError_t e = hipLaunchCooperativeKernel((const void*)mega_fwd, dim3(grid), dim3(512), args, LDS_BYTES, stream);
    if (e != hipSuccess) fprintf(stderr, "cooperative launch failed: %s (grid %d)\n", hipGetErrorString(e), grid);
#else
    for (int ph = 0; ph < NPHASE; ++ph) { p.ph_lo = ph; p.ph_hi = ph + 1; hipLaunchKernelGGL(mega_fwd, dim3(grid), dim3(512), LDS_BYTES, stream, p); }
#endif
}
```

```cpp
#include <hip/hip_runtime.h>
#include <hip/hip_cooperative_groups.h>
#include <cstdio>
#include <cstdint>
namespace cg = cooperative_groups;
#ifndef MK_LAUNCHES
#define MK_LAUNCHES 1
#endif
namespace pg8 {
#define PG8_LAS __attribute__((address_space(3)))
typedef unsigned short bf16_t;
typedef short bf16x8 __attribute__((ext_vector_type(8)));
typedef float f32x4 __attribute__((ext_vector_type(4)));
typedef unsigned u32x4 __attribute__((ext_vector_type(4)));
constexpr int BM = 256, BK = 64, HALF = 128, HTB = HALF * BK * 2  , STAGE_BYTES = 8 * HTB, NXCD = 8, WGM = 4;

__host__ __device__ __forceinline__ int lds_byte(int r, int c) { const int st = (r >> 4) * 2 + (c >> 5), rr = r & 15, cc = c & 31, ob = rr * 64 + cc * 2; return st * 1024 + (ob ^ (((ob >> 9) & 1) << 5)); }
__host__ __device__ __forceinline__ void stage_rc(int b, int& R, int& C) { const int st = b / 1024, sb = b % 1024, swz = sb ^ (((sb >> 9) & 1) << 5); R = (st >> 1) * 16 + swz / 64; C = (st & 1) * 32 + (swz % 64) / 2; }
__host__ __device__ __forceinline__ int perm32(int rho) { const int n = rho >> 4, i = rho & 15; return 8 * (i >> 2) + 4 * n + (i & 3); }
struct Unit { int pm, pn; };
struct Gemm { const bf16_t* A; const bf16_t* Bt; int M, N, K; };

struct StaticOrder {
    int nM, nN, nwg, G, c;
    __host__ __device__ void init(int M, int N, int G_, int c_) { nM = M / BM; nN = N / BM; nwg = nM * nN; G = G_; c = c_; }
    __host__ __device__ bool next(int i, Unit& u) const {
        const long L = (long)i * G + c; if (L >= nwg) return false;
        int wgid = (int)L; { const int q = nwg / NXCD, r = nwg % NXCD, xcd = wgid % NXCD, off = wgid / NXCD; wgid = (xcd < r ? xcd * (q + 1) : r * (q + 1) + (xcd - r) * q) + off; }
        const int nig = WGM * nN, gid = wgid / nig, fm = gid * WGM, gsz = (nM - fm) < WGM ? (nM - fm) : WGM;
        u.pm = fm + ((wgid % nig) % gsz); u.pn = (wgid % nig) / gsz; return true;
    }
    __device__ __forceinline__ void a_ready(const Unit&) const {}
    __device__ __forceinline__ void done(const Unit&) const {}
};
typedef __bf16 bf16v2_t __attribute__((ext_vector_type(2)));
typedef float f32v2_t __attribute__((ext_vector_type(2)));
__device__ __forceinline__ unsigned cvt_pk_bf16_c(float lo, float hi) { f32v2_t v = {lo, hi}; bf16v2_t b = __builtin_convertvector(v, bf16v2_t); unsigned r; __builtin_memcpy(&r, &b, 4); return r; }
__device__ __forceinline__ unsigned cvt_pk_bf16(float lo, float hi) { unsigned r; asm volatile("v_cvt_pk_bf16_f32 %0, %1, %2" : "=v"(r) : "v"(lo), "v"(hi)); return r; }
template <class Epi, class Sched, bool STAMP = false>
__device__ __forceinline__ void gemm_phase(PG8_LAS unsigned char* lds, const Gemm g, const Sched& S, const Epi& E, unsigned long long* stamps) {
    const int tid = threadIdx.x, wid = __builtin_amdgcn_readfirstlane(tid >> 6), lane = tid & 63, wr = wid >> 2, wc = wid & 3, fr = lane & 15, fq = lane >> 4;
    const int K = g.K, nt = K / BK;
    int ts_lo = 0, ts_hi = 0, nts = 0; const unsigned long long rt_entry = STAMP ? (unsigned long long)wall_clock64() : 0ull;
#define PG8_STAMP() do { if (STAMP && wid == 0 && nts < 64) { const unsigned long long _c = (unsigned long long)clock64(); \
        ts_lo = (lane == nts) ? (int)(unsigned)_c : ts_lo; ts_hi = (lane == nts) ? (int)(unsigned)(_c >> 32) : ts_hi; ++nts; } } while (0)
    PG8_STAMP();
    unsigned voffA[2], voffB[2];
#pragma unroll
    for (int i = 0; i < 2; ++i) { int R, C; stage_rc(tid * 16 + i * 8192, R, C); const int Rb = Epi::PERM ? ((R & ~31) + perm32(R & 31)) : R;
        voffA[i] = (unsigned)(R * K + C) * 2u; voffB[i] = (unsigned)(Rb * K + C) * 2u; }
    const size_t kstep = (size_t)(BK * 2);
    const size_t hstep = (size_t)HALF * K * 2;
    const size_t tstep = 2 * hstep;
    const unsigned ldsw = (unsigned)wid * 1024u;
    const int aoff = lds_byte(wr * 64 + fr, fq * 8), boff = lds_byte(wc * 32 + fr, fq * 8);
#define PG8_SA(b, h) (((b) * 2 + (h)) * HTB)
#define PG8_SB(b, h) ((4 + (b) * 2 + (h)) * HTB)
#define PG8_STAGE(bufoff, gbase, voff) do { _Pragma("unroll") for (int _i = 0; _i < 2; ++_i) \
        __builtin_amdgcn_global_load_lds((const unsigned*)((const char*)(gbase) + (voff)[_i]), (PG8_LAS unsigned*)(lds + (bufoff) + ldsw + _i * 8192), 16, 0, 0); } while (0)
#define PG8_LDA(dst, b, h) do { _Pragma("unroll") for (int m = 0; m < 4; ++m) _Pragma("unroll") for (int k = 0; k < 2; ++k) dst[m][k] = *(const PG8_LAS bf16x8*)(lds + PG8_SA(b, h) + aoff + m * 2048 + k * 1024); } while (0)
#define PG8_LDB(dst, b, h) do { _Pragma("unroll") for (int n = 0; n < 2; ++n) _Pragma("unroll") for (int k = 0; k < 2; ++k) dst[n][k] = *(const PG8_LAS bf16x8*)(lds + PG8_SB(b, h) + boff + n * 2048 + k * 1024); } while (0)
#define PG8_MMA(ai, bj, At, Bt) do { __builtin_amdgcn_s_setprio(1); _Pragma("unroll") for (int m = 0; m < 4; ++m) _Pragma("unroll") for (int n = 0; n < 2; ++n) _Pragma("unroll") for (int k = 0; k < 2; ++k) \
        acc[ai][bj][m][n] = __builtin_amdgcn_mfma_f32_16x16x32_bf16(Bt[n][k], At[m][k], acc[ai][bj][m][n], 0, 0, 0); __builtin_amdgcn_s_setprio(0); } while (0)
#define PG8_WAIT_V(n) asm volatile("s_waitcnt vmcnt(" #n ")" ::: "memory")
#define PG8_WAIT_L(n) asm volatile("s_waitcnt lgkmcnt(" #n ")" ::: "memory")
#define PG8_BAR __builtin_amdgcn_s_barrier()
#define PG8_SCHED __builtin_amdgcn_sched_barrier(0)
    Unit cur, nxt; int ui = 0;
    if (!S.next(0, cur)) return;
    f32x4 acc[2][2][4][2];
#pragma unroll
    for (int a = 0; a < 2; ++a)
#pragma unroll
        for (int b = 0; b < 2; ++b)
#pragma unroll
            for (int m = 0; m < 4; ++m)
#pragma unroll
                for (int n = 0; n < 2; ++n) acc[a][b][m][n] = (f32x4){0.f, 0.f, 0.f, 0.f};
    bf16x8 At[4][2], B0[2][2], B1[2][2];
    const char* cA = (const char*)g.A + (size_t)cur.pm * tstep; const char* cB = (const char*)g.Bt + (size_t)cur.pn * tstep;
    S.a_ready(cur);
    PG8_STAGE(PG8_SB(0, 0), cB, voffB); PG8_STAGE(PG8_SA(0, 0), cA, voffA); PG8_STAGE(PG8_SB(0, 1), cB + hstep, voffB); PG8_STAGE(PG8_SA(0, 1), cA + hstep, voffA);
    if (wr == 1) PG8_BAR;
    PG8_WAIT_V(4); PG8_BAR;
    PG8_STAGE(PG8_SB(1, 0), cB + kstep, voffB); PG8_STAGE(PG8_SA(1, 0), cA + kstep, voffA); PG8_STAGE(PG8_SB(1, 1), cB + hstep + kstep, voffB);
    PG8_WAIT_V(6); PG8_BAR;
    PG8_STAMP();
    for (;;) {
        const bool has_next = S.next(ui + 1, nxt);
        const char* nA = has_next ? (const char*)g.A + (size_t)nxt.pm * tstep : cA; const char* nB = has_next ? (const char*)g.Bt + (size_t)nxt.pn * tstep : cB;
        for (int t = 0; t < nt; t += 2) {
            const bool last = (t == nt - 2);
            const char* a1 = cA + (size_t)(t + 1) * kstep;
            const char* a2 = last ? nA : cA + (size_t)(t + 2) * kstep; const char* b2 = last ? nB : cB + (size_t)(t + 2) * kstep;
            const char* a3 = a2 + kstep; const char* b3 = b2 + kstep;
            if (last && has_next) S.a_ready(nxt);
            PG8_LDB(B0, 0, 0); PG8_SCHED; PG8_LDA(At, 0, 0); PG8_STAGE(PG8_SA(1, 1), a1 + hstep, voffA);
            PG8_WAIT_L(8); PG8_BAR; PG8_WAIT_L(0); PG8_MMA(0, 0, At, B0); PG8_BAR; PG8_SCHED;
            PG8_LDB(B1, 0, 1); PG8_STAGE(PG8_SB(0, 0), b2, voffB);
            PG8_BAR; PG8_WAIT_L(0); PG8_MMA(0, 1, At, B1); PG8_BAR;
            PG8_LDA(At, 0, 1); PG8_STAGE(PG8_SA(0, 0), a2, voffA);
            PG8_BAR; PG8_WAIT_L(0); PG8_MMA(1, 0, At, B0); PG8_BAR; PG8_SCHED;
            PG8_STAGE(PG8_SB(0, 1), b2 + hstep, voffB);
            PG8_WAIT_V(6); PG8_BAR; PG8_MMA(1, 1, At, B1); PG8_BAR;
            PG8_LDB(B0, 1, 0); PG8_SCHED; PG8_LDA(At, 1, 0); PG8_STAGE(PG8_SA(0, 1), a2 + hstep, voffA);
            PG8_WAIT_L(8); PG8_BAR; PG8_WAIT_L(0); PG8_MMA(0, 0, At, B0); PG8_BAR; PG8_SCHED;
            PG8_LDB(B1, 1, 1); PG8_STAGE(PG8_SB(1, 0), b3, voffB);
            PG8_BAR; PG8_WAIT_L(0); PG8_MMA(0, 1, At, B1); PG8_BAR;
            PG8_LDA(At, 1, 1); PG8_STAGE(PG8_SA(1, 0), a3, voffA);
            PG8_BAR; PG8_WAIT_L(0); PG8_MMA(1, 0, At, B0); PG8_BAR; PG8_SCHED;
            PG8_STAGE(PG8_SB(1, 1), b3 + hstep, voffB);
            PG8_WAIT_V(6); PG8_BAR; PG8_MMA(1, 1, At, B1); PG8_BAR;
        }
        PG8_STAMP();
        if constexpr (!Epi::AFTER_DRAIN) { E(acc, cur, wr, wc, fr, fq); S.done(cur); }
        PG8_STAMP();
        if (!has_next) break;
#pragma unroll
        for (int a = 0; a < 2; ++a)
#pragma unroll
            for (int b = 0; b < 2; ++b)
#pragma unroll
                for (int m = 0; m < 4; ++m)
#pragma unroll
                    for (int n = 0; n < 2; ++n) acc[a][b][m][n] = (f32x4){0.f, 0.f, 0.f, 0.f};
        cur = nxt; cA = nA; cB = nB; ++ui;
    }
    PG8_WAIT_V(0);
    if (wr == 0) PG8_BAR;
    PG8_BAR;
    if constexpr (Epi::AFTER_DRAIN) { E.fused(acc, cur, wr, wc, fr, fq, lds, wid, lane); S.done(cur); }
    PG8_STAMP();
    if (STAMP && wid == 0) { stamps[lane] = lane < nts ? (((unsigned long long)(unsigned)ts_hi << 32) | (unsigned)ts_lo) : 0ull;
        if (lane == 62) stamps[62] = rt_entry; if (lane == 63) stamps[63] = (unsigned long long)wall_clock64(); }
#undef PG8_STAMP
#undef PG8_SA
#undef PG8_SB
#undef PG8_STAGE
#undef PG8_LDA
#undef PG8_LDB
#undef PG8_MMA
#undef PG8_WAIT_V
#undef PG8_WAIT_L
#undef PG8_BAR
#undef PG8_SCHED
}
}

#define XB_TMO      128
#define XB_XCNT(j)  (256  + 64 * (j))
#define XB_XSUB(j)  (1280 + 64 * (j))
#define XB_XGEN(j)  (2304 + 64 * (j))
#define XB_TOP      3328
#define XB_TOPGEN   3392
#define XCD_BAR_WORDS 3456
#define XB_SPIN_CAP (1u << 18)
#define LAS __attribute__((address_space(3)))

__device__ __forceinline__ unsigned xb_ld(unsigned* p)              { return __hip_atomic_load(p, __ATOMIC_RELAXED, __HIP_MEMORY_SCOPE_AGENT); }
__device__ __forceinline__ unsigned xb_add(unsigned* p, unsigned v) { return __hip_atomic_fetch_add(p, v, __ATOMIC_RELAXED, __HIP_MEMORY_SCOPE_AGENT); }
__device__ __forceinline__ unsigned xb_xcc_id() { return (unsigned)__builtin_amdgcn_s_getreg((3 << 11) | 20) & 0xFu; }
#define XB_SPIN(cond, bar) do { unsigned _sp = 0; while (cond) { __builtin_amdgcn_s_sleep(1); \
    if ((++_sp & 255u) == 0u) { if (xb_ld(&(bar)[XB_TMO])) break; if (_sp > XB_SPIN_CAP) { atomicAdd(&(bar)[XB_TMO], 1u); break; } } } } while (0)

struct XcdBarrier {
    unsigned* bar; unsigned x;
    volatile LAS unsigned* st;
};

__device__ __forceinline__ XcdBarrier xcd_barrier_post(unsigned* bar, volatile LAS unsigned* st) {
    XcdBarrier b; b.bar = bar; b.x = xb_xcc_id(); b.st = st;
    if (threadIdx.x == 0) (void)xb_add(&bar[XB_XCNT(b.x)], 1u);
    return b;
}
__device__ __forceinline__ void xcd_barrier_complete(unsigned* bar, unsigned x, unsigned& nloc, unsigned& nx) {
    const unsigned G = gridDim.x * gridDim.y * gridDim.z;
    unsigned sum, cnt, mine, sp = 0u;
    for (;;) {
        sum = 0u; cnt = 0u; mine = 0u;
#pragma unroll
        for (unsigned j = 0; j < 16; ++j) { const unsigned c = xb_ld(&bar[XB_XCNT(j)]); sum += c; cnt += (c > 0u) ? 1u : 0u; mine = (j == x) ? c : mine; }
        if (sum == G) break;
        __builtin_amdgcn_s_sleep(1);
        if ((++sp & 255u) == 0u) { if (xb_ld(&bar[XB_TMO])) break; if (sp > XB_SPIN_CAP) { atomicAdd(&bar[XB_TMO], 1u); break; } }
    }
    nloc = mine > 0u ? mine : 1u; nx = cnt > 0u ? cnt : 1u;
}

__device__ __forceinline__ void xcd_barrier(const XcdBarrier& b) {
    asm volatile("s_waitcnt vmcnt(0)" ::: "memory");
    __syncthreads();
    if (threadIdx.x == 0) {
        unsigned* bar = b.bar;
        __builtin_amdgcn_s_waitcnt(0);
        unsigned nloc = b.st[0], nx = b.st[1];
        if (nloc == 0u) { xcd_barrier_complete(bar, b.x, nloc, nx); b.st[0] = nloc; b.st[1] = nx; }
        const unsigned old = xb_add(&bar[XB_XSUB(b.x)], 1u);
        const unsigned gen = old / nloc;
        if (old + 1u == (gen + 1u) * nloc) {
            __builtin_amdgcn_fence(__ATOMIC_RELEASE, "agent");
            asm volatile("s_waitcnt vmcnt(0)" ::: "memory");
            const unsigned og = xb_add(&bar[XB_TOP], 1u);
            const unsigned tg = og / nx;
            if (og + 1u == (tg + 1u) * nx) xb_add(&bar[XB_TOPGEN], 1u);
            else XB_SPIN(xb_ld(&bar[XB_TOPGEN]) == tg, bar);
            __builtin_amdgcn_fence(__ATOMIC_ACQUIRE, "agent");
            xb_add(&bar[XB_XGEN(b.x)], 1u);
            asm volatile("s_waitcnt vmcnt(0)" ::: "memory");
        } else {
            XB_SPIN(xb_ld(&bar[XB_XGEN(b.x)]) == gen, bar);
            __builtin_amdgcn_fence(__ATOMIC_ACQUIRE, "agent");
            asm volatile("s_waitcnt vmcnt(0)" ::: "memory");
        }
    }
    __syncthreads();
}


using pg8::bf16_t; using pg8::bf16x8; using pg8::f32x4; using pg8::u32x4; using pg8::cvt_pk_bf16;
typedef unsigned u32x2 __attribute__((ext_vector_type(2)));
constexpr int DM = 2048, FF = 5632, NPR = 8192, R_META = 8192, R_SAMP = 8208, RT = 8448;
constexpr int UW = 8720;
constexpr int U_GQ = 0, U_GK = 512, U_GV = 1024, U_GR = 2048, U_SQ = 3072, U_SK = 4096, U_SV = 4352, U_GA = 4608, U_GB = 6656, U_GAD = 8704;
constexpr int NIN_PAD = 8960;
constexpr float EPSV = 1e-6f;
constexpr size_t O_YP = 0, O_YS = 16777216, O_PMK = 16842752, O_PMV = 16859136, O_PWK = 16875520, O_PWV = 17006592, O_PGLA = 17137664,
                 O_SWK = 17661952, O_SWV = 18710528, O_SGLA = 19759104;
constexpr size_t WS_BT1IN = 0;
constexpr size_t WS_BT1OUT = WS_BT1IN + (size_t)11264 * 2048 * 2;
constexpr size_t WS_BTIN = WS_BT1OUT + (size_t)2048 * 5632 * 2;
constexpr size_t WS_BTGO = WS_BTIN + (size_t)NIN_PAD * 2048 * 2;
constexpr size_t WS_BTSO = WS_BTGO + (size_t)2048 * 1024 * 2;
constexpr size_t WS_BTOUT = WS_BTSO + (size_t)2048 * 1024 * 2;
constexpr size_t WS_BT2IN = WS_BTOUT + (size_t)2048 * 2048 * 2;
constexpr size_t WS_BT2OUT = WS_BT2IN + (size_t)11264 * 2048 * 2;
constexpr size_t WS_A = WS_BT2OUT + (size_t)2048 * 5632 * 2;
constexpr size_t WS_UH = WS_A + (size_t)RT * 2048 * 2;
constexpr size_t WS_OG = WS_UH + (size_t)RT * UW * 2;
constexpr size_t WS_O = WS_OG + (size_t)RT * 1024 * 2;
constexpr size_t WS_PART = WS_O + (size_t)RT * 1024 * 2;
constexpr size_t WS_HX = WS_PART + (size_t)RT * 32 * 4;
constexpr size_t WS_PARTX = WS_HX + (size_t)256 * 2048 * 4;
constexpr size_t WS_QT = WS_PARTX + (size_t)64 * 128 * 4;
constexpr size_t WS_KH = WS_QT + (size_t)512 * 8192 * 2;
constexpr size_t WS_ATT = WS_KH + (size_t)512 * 8192 * 2;
constexpr size_t WS_DEC = WS_ATT + (size_t)512 * 4096 * 2;
constexpr size_t WS_BAR = WS_DEC + (size_t)512 * 128 * 4;
constexpr int CNT_WORDS = 64 * 40;
constexpr size_t WS_CNT = WS_BAR + (size_t)XCD_BAR_WORDS * 4;
constexpr size_t WS_END = WS_CNT + (size_t)CNT_WORDS * 4;
constexpr int LDS_BYTES = 131072 + 16;
constexpr int NPHASE = 12;

struct Params { const float* in[25]; float* out; unsigned char* ws; int ph_lo, ph_hi; };

__device__ __forceinline__ float bf2f(unsigned short b) { return __uint_as_float(((unsigned)b) << 16); }
__device__ __forceinline__ float bflo(unsigned w) { return __uint_as_float(w << 16); }
__device__ __forceinline__ float bfhi(unsigned w) { return __uint_as_float(w & 0xffff0000u); }
__device__ __forceinline__ unsigned short f2bf(float f) { return (unsigned short)(cvt_pk_bf16(f, 0.f) & 0xffffu); }
__device__ __forceinline__ float wave_sum(float v) {
#pragma unroll
    for (int o = 1; o < 64; o <<= 1) v += __shfl_xor(v, o);
    return v;
}
__device__ __forceinline__ float wave_max(float v) {
#pragma unroll
    for (int o = 1; o < 64; o <<= 1) v = fmaxf(v, __shfl_xor(v, o));
    return v;
}
__device__ __forceinline__ float sigmoidf_(float x) { return 1.f / (1.f + __expf(-x)); }
__device__ __forceinline__ float siluf_(float x) { return x / (1.f + __expf(-x)); }
__device__ __forceinline__ float logsigf_(float x) { return fminf(x, 0.f) - log1pf(__expf(-fabsf(x))); }
__device__ __forceinline__ f32x4 mfma16(bf16x8 a, bf16x8 b, f32x4 c) { return __builtin_amdgcn_mfma_f32_16x16x32_bf16(a, b, c, 0, 0, 0); }
__device__ __forceinline__ u32x2 pack4(f32x4 v) { u32x2 r; r.x = cvt_pk_bf16(v[0], v[1]); r.y = cvt_pk_bf16(v[2], v[3]); return r; }
__device__ __forceinline__ u32x2 pack4c(f32x4 v) { u32x2 r; r.x = pg8::cvt_pk_bf16_c(v[0], v[1]); r.y = pg8::cvt_pk_bf16_c(v[2], v[3]); return r; }
__device__ __forceinline__ float rstd_of(const float* part, int row) {
    const f32x4* p = (const f32x4*)(part + (size_t)row * 32);
    f32x4 s = p[0];
#pragma unroll
    for (int i = 1; i < 8; ++i) s += p[i];
    return rsqrtf(((s[0] + s[1]) + (s[2] + s[3])) * (1.f / 2048.f) + EPSV);
}

__device__ __forceinline__ float rstd_x(const float* partx, int row) {
    const int rl = row - NPR; if (rl >= 64) return 1.f;
    const f32x4* p = (const f32x4*)(partx + (size_t)rl * 128);
    f32x4 s = p[0];
#pragma unroll
    for (int i = 1; i < 32; ++i) s += p[i];
    return rsqrtf(((s[0] + s[1]) + (s[2] + s[3])) * (1.f / 2048.f) + EPSV);
}

template <int MODE> struct Epi {
    static constexpr bool PERM = false, AFTER_DRAIN = (MODE == 5);
    template <class LP> __device__ __forceinline__ void fused(const f32x4 (&acc)[2][2][4][2], const pg8::Unit& u, int wr, int wc, int fr, int fq, LP, int, int) const { (*this)(acc, u, wr, wc, fr, fq); }
    bf16_t* outb; float* hmain; const float* hsrc; float* hx; const float* part_in; const float* partx; float* part_out; const float* gvec; const bf16_t* U; const float* gbias; float scale; int uoff, boff; unsigned* cnt; const float* fnorm;
    __device__ __forceinline__ void operator()(const f32x4 (&acc)[2][2][4][2], const pg8::Unit& u, int wr, int wc, int fr, int fq) const {
        const int row0 = u.pm * 256 + wr * 64 + fr;
        if constexpr (MODE == 0) {
            float rsv[8];
#pragma unroll
            for (int i = 0; i < 8; ++i) rsv[i] = part_in[row0 + (i >> 2) * 128 + (i & 3) * 16];
#pragma unroll
            for (int i = 0; i < 8; ++i) rsv[i] = rsqrtf(rsv[i] * (1.f / 2048.f) + EPSV);
            const int j0 = u.pn * 128 + wc * 16 + 4 * fq;
#pragma unroll
            for (int ai = 0; ai < 2; ++ai)
#pragma unroll
                for (int m = 0; m < 4; ++m) {
                    const int row = row0 + ai * 128 + m * 16; const float rs = rsv[ai * 4 + m];
#pragma unroll
                    for (int bj = 0; bj < 2; ++bj) {
                        f32x4 a = acc[ai][bj][m][0] * rs, b = acc[ai][bj][m][1] * rs, hv;
#pragma unroll
                        for (int j = 0; j < 4; ++j) hv[j] = siluf_(a[j]) * b[j];
                        *(u32x2*)(outb + (size_t)row * FF + j0 + bj * 64) = pack4(hv);
                    }
                }
        } else if constexpr (MODE == 1) {
            float* hb = hmain; const float* hs = hsrc;
            const int col0 = u.pn * 256 + wc * 32 + 4 * fq;
            f32x4 gv[4];
#pragma unroll
            for (int q = 0; q < 4; ++q) gv[q] = gvec ? *(const f32x4*)(gvec + col0 + (q >> 1) * 128 + (q & 1) * 16) : (f32x4){0.f, 0.f, 0.f, 0.f};
            f32x4 hn[4];
#pragma unroll
            for (int q = 0; q < 4; ++q) hn[q] = *(const f32x4*)(hs + (size_t)row0 * DM + col0 + (q >> 1) * 128 + (q & 1) * 16);
#pragma unroll
            for (int i = 0; i < 8; ++i) {
                const int ai = i >> 2, m = i & 3, row = row0 + ai * 128 + m * 16; float ss = 0.f;
                f32x4 hc[4];
#pragma unroll
                for (int q = 0; q < 4; ++q) hc[q] = hn[q];
                if (i < 7) {
                    const int rown = row0 + ((i + 1) >> 2) * 128 + ((i + 1) & 3) * 16;
#pragma unroll
                    for (int q = 0; q < 4; ++q) hn[q] = *(const f32x4*)(hs + (size_t)rown * DM + col0 + (q >> 1) * 128 + (q & 1) * 16);
                }
#pragma unroll
                for (int q = 0; q < 4; ++q) {
                    const int bj = q >> 1, n = q & 1, col = col0 + bj * 128 + n * 16;
                    const f32x4 hv = hc[q] + acc[ai][bj][m][n] * scale;
                    *(f32x4*)(hb + (size_t)row * DM + col) = hv;
                    if (gvec) {
                        ss += (hv[0] * hv[0] + hv[1] * hv[1]) + (hv[2] * hv[2] + hv[3] * hv[3]);
                        *(u32x2*)(outb + (size_t)row * DM + col) = pack4(hv * gv[q]);
                    }
                }
                if (gvec) {
                    ss += __shfl_xor(ss, 16); ss += __shfl_xor(ss, 32);
                    if (fq == 0) unsafeAtomicAdd(part_out + row, ss);
                }
            }
        } else if constexpr (MODE == 5) {
            f32x4 (&hv)[2][2][4][2] = const_cast<f32x4 (&)[2][2][4][2]>(acc);
            float* hb = hmain; const float* hs = hsrc;
            const int col0 = u.pn * 256 + wc * 32 + 4 * fq;
            f32x4 hn[4];
#pragma unroll
            for (int q = 0; q < 4; ++q) hn[q] = *(const f32x4*)(hs + (size_t)row0 * DM + col0 + (q >> 1) * 128 + (q & 1) * 16);
#pragma unroll
            for (int i = 0; i < 8; ++i) {
                const int ai = i >> 2, m = i & 3, row = row0 + ai * 128 + m * 16; float ss = 0.f;
                f32x4 hc[4];
#pragma unroll
                for (int q = 0; q < 4; ++q) hc[q] = hn[q];
                if (i < 7) {
                    const int rown = row0 + ((i + 1) >> 2) * 128 + ((i + 1) & 3) * 16;
#pragma unroll
                    for (int q = 0; q < 4; ++q) hn[q] = *(const f32x4*)(hs + (size_t)rown * DM + col0 + (q >> 1) * 128 + (q & 1) * 16);
                }
#pragma unroll
                for (int q = 0; q < 4; ++q) {
                    const int bj = q >> 1, n = q & 1;
                    const f32x4 v = hc[q] + acc[ai][bj][m][n] * scale;
                    hv[ai][bj][m][n] = v;
                    ss += (v[0] * v[0] + v[1] * v[1]) + (v[2] * v[2] + v[3] * v[3]);
                }
                ss += __shfl_xor(ss, 16); ss += __shfl_xor(ss, 32);
                if (fq == 0) unsafeAtomicAdd(part_out + row, ss);
            }
            asm volatile("s_waitcnt vmcnt(0)" ::: "memory");
            unsigned* cw = cnt + 64 * u.pm;
            if (fr == 0 && fq == 0) (void)__hip_atomic_fetch_add(cw, 1u, __ATOMIC_RELAXED, __HIP_MEMORY_SCOPE_AGENT);
            { unsigned sp = 0; while ((unsigned)__builtin_amdgcn_readfirstlane(__hip_atomic_load(cw, __ATOMIC_RELAXED, __HIP_MEMORY_SCOPE_AGENT)) < 64u) { __builtin_amdgcn_s_sleep(2); if (++sp > (1u << 20)) break; } }
            f32x4 fv[4];
#pragma unroll
            for (int q = 0; q < 4; ++q) fv[q] = *(const f32x4*)(fnorm + col0 + (q >> 1) * 128 + (q & 1) * 16);
            float rsv[8];
#pragma unroll
            for (int i = 0; i < 8; ++i) rsv[i] = __hip_atomic_load(part_out + row0 + (i >> 2) * 128 + (i & 3) * 16, __ATOMIC_RELAXED, __HIP_MEMORY_SCOPE_AGENT);
#pragma unroll
            for (int i = 0; i < 8; ++i) rsv[i] = rsqrtf(rsv[i] * (1.f / 2048.f) + EPSV);
#pragma unroll
            for (int i = 0; i < 8; ++i) {
                const int ai = i >> 2, m = i & 3, row = row0 + ai * 128 + m * 16;
#pragma unroll
                for (int q = 0; q < 4; ++q) { const int bj = q >> 1, n = q & 1; *(f32x4*)(hb + (size_t)row * DM + col0 + bj * 128 + n * 16) = hv[ai][bj][m][n] * rsv[i] * fv[q]; }
            }
        } else if constexpr (MODE == 2) {
            float rsv[8];
#pragma unroll
            for (int i = 0; i < 8; ++i) rsv[i] = part_in[row0 + (i >> 2) * 128 + (i & 3) * 16];
#pragma unroll
            for (int i = 0; i < 8; ++i) rsv[i] = rsqrtf(rsv[i] * (1.f / 2048.f) + EPSV);
            const int col0 = u.pn * 256 + wc * 32 + 4 * fq;
#pragma unroll
            for (int ai = 0; ai < 2; ++ai)
#pragma unroll
                for (int m = 0; m < 4; ++m) {
                    const int row = row0 + ai * 128 + m * 16; const float rs = rsv[ai * 4 + m];
#pragma unroll
                    for (int bj = 0; bj < 2; ++bj)
#pragma unroll
                        for (int n = 0; n < 2; ++n) {
                            const int col = col0 + bj * 128 + n * 16;
                            if (col < UW) *(u32x2*)(outb + (size_t)row * UW + col) = pack4(acc[ai][bj][m][n] * rs);
                        }
                }
        } else {
            const int col0 = u.pn * 256 + wc * 32 + 4 * fq;
            f32x4 gbv[4];
#pragma unroll
            for (int q = 0; q < 4; ++q) gbv[q] = *(const f32x4*)(gbias + boff + col0 + (q >> 1) * 128 + (q & 1) * 16);
            u32x2 gn[4], on[4];
#pragma unroll
            for (int q = 0; q < 4; ++q) {
                gn[q] = *(const u32x2*)(U + (size_t)row0 * UW + uoff + col0 + (q >> 1) * 128 + (q & 1) * 16);
                if constexpr (MODE == 4) on[q] = *(const u32x2*)(outb + (size_t)row0 * DM + col0 + (q >> 1) * 128 + (q & 1) * 16);
            }
#pragma unroll
            for (int i = 0; i < 8; ++i) {
                const int ai = i >> 2, m = i & 3, row = row0 + ai * 128 + m * 16;
                u32x2 gc[4], oc[4];
#pragma unroll
                for (int q = 0; q < 4; ++q) { gc[q] = gn[q]; if constexpr (MODE == 4) oc[q] = on[q]; }
                if (i < 7) {
                    const int rown = row0 + ((i + 1) >> 2) * 128 + ((i + 1) & 3) * 16;
#pragma unroll
                    for (int q = 0; q < 4; ++q) {
                        gn[q] = *(const u32x2*)(U + (size_t)rown * UW + uoff + col0 + (q >> 1) * 128 + (q & 1) * 16);
                        if constexpr (MODE == 4) on[q] = *(const u32x2*)(outb + (size_t)rown * DM + col0 + (q >> 1) * 128 + (q & 1) * 16);
                    }
                }
#pragma unroll
                for (int q = 0; q < 4; ++q) {
                    const int bj = q >> 1, n = q & 1, col = col0 + bj * 128 + n * 16;
                    const u32x2 gw = gc[q]; const f32x4 gb = gbv[q];
                    f32x4 v; const f32x4 a = acc[ai][bj][m][n];
                    v[0] = sigmoidf_(bflo(gw.x) + gb[0]) * a[0]; v[1] = sigmoidf_(bfhi(gw.x) + gb[1]) * a[1];
                    v[2] = sigmoidf_(bflo(gw.y) + gb[2]) * a[2]; v[3] = sigmoidf_(bfhi(gw.y) + gb[3]) * a[3];
                    if constexpr (MODE == 4) { const u32x2 o = oc[q]; v[0] += bflo(o.x); v[1] += bfhi(o.x); v[2] += bflo(o.y); v[3] += bfhi(o.y); }
                    *(u32x2*)(outb + (size_t)row * DM + col) = pack4(v);
                }
            }
        }
    }
};

template <int MODE> __device__ __forceinline__ void run_gemm(PG8_LAS unsigned char* lds, const bf16_t* A, const bf16_t* Bt, int M, int N, int K, const Epi<MODE>& E) {
    pg8::Gemm g; g.A = A; g.Bt = Bt; g.M = M; g.N = N; g.K = K;
    pg8::StaticOrder S; S.init(M, N, (int)gridDim.x, (int)blockIdx.x);
    pg8::gemm_phase<Epi<MODE>, pg8::StaticOrder, false>(lds, g, S, E, nullptr);
}


__device__ __forceinline__ void skinny_acc(const bf16_t* A, int lda, const bf16_t* Bt, int K, int n0, int w, int fr, int fq, f32x4 (&acc)[4]) {
    const int ks = K >> 3, kbeg = w * ks;
    const bf16_t* bp = Bt + (size_t)(n0 + fr) * K + kbeg + 8 * fq;
    const bf16_t* ap = A + (size_t)fr * lda + kbeg + 8 * fq;
#pragma unroll 4
    for (int k0 = 0; k0 < ks; k0 += 32) {
        const bf16x8 bv = *(const bf16x8*)(bp + k0);
#pragma unroll
        for (int mt = 0; mt < 4; ++mt) { const bf16x8 av = *(const bf16x8*)(ap + (size_t)(16 * mt) * lda + k0); acc[mt] = mfma16(bv, av, acc[mt]); }
    }
}
template <int MODE> __device__ __forceinline__ void skinny_phase(unsigned char* smem, const bf16_t* A1, int lda1, const bf16_t* B1, int K, const bf16_t* A2, const bf16_t* B2,
                                                             bf16_t* outb, float* hx, float* partx, const float* gvec, float scale, const bf16_t* U, const float* gbias, unsigned* cnt = nullptr, const float* fnorm = nullptr, float* ys = nullptr) {
    const int tid = threadIdx.x, lane = tid & 63, w = tid >> 6, fr = lane & 15, fq = lane >> 4;
    f32x4* red = (f32x4*)smem;
    for (int c = blockIdx.x; c < 128; c += gridDim.x) {
        const int n0 = 16 * c;
        f32x4 acc[4] = {(f32x4){0.f, 0.f, 0.f, 0.f}, (f32x4){0.f, 0.f, 0.f, 0.f}, (f32x4){0.f, 0.f, 0.f, 0.f}, (f32x4){0.f, 0.f, 0.f, 0.f}};
        skinny_acc(A1, lda1, B1, K, n0, w, fr, fq, acc);
        __syncthreads();
#pragma unroll
        for (int mt = 0; mt < 4; ++mt) red[(w * 4 + mt) * 64 + lane] = acc[mt];
        if constexpr (MODE == 34) {
            f32x4 acc2[4] = {(f32x4){0.f, 0.f, 0.f, 0.f}, (f32x4){0.f, 0.f, 0.f, 0.f}, (f32x4){0.f, 0.f, 0.f, 0.f}, (f32x4){0.f, 0.f, 0.f, 0.f}};
            skinny_acc(A2, lda1, B2, K, n0, w, fr, fq, acc2);
#pragma unroll
            for (int mt = 0; mt < 4; ++mt) red[((8 + w) * 4 + mt) * 64 + lane] = acc2[mt];
        }
        __syncthreads();
        if (tid < 256) {
            const int mt = w, rl = 16 * mt + fr, row = NPR + rl, col = n0 + 4 * fq;
            f32x4 v = red[mt * 64 + lane];
#pragma unroll
            for (int ww = 1; ww < 8; ++ww) v += red[(ww * 4 + mt) * 64 + lane];
            if constexpr (MODE == 1 || MODE == 15) {
                float* hp = hx + (size_t)rl * DM + col;
                const f32x4 hv = *(const f32x4*)hp + v * scale;
                *(f32x4*)hp = hv;
                if (gvec) {
                    const f32x4 g = *(const f32x4*)(gvec + col);
                    float ss = (hv[0] * hv[0] + hv[1] * hv[1]) + (hv[2] * hv[2] + hv[3] * hv[3]);
                    *(u32x2*)(outb + (size_t)row * DM + col) = pack4(hv * g);
                    ss += __shfl_xor(ss, 16); ss += __shfl_xor(ss, 32);
                    if (fq == 0) unsafeAtomicAdd(partx + row, ss);
                }
                if constexpr (MODE == 15) {
                    float ss = (hv[0] * hv[0] + hv[1] * hv[1]) + (hv[2] * hv[2] + hv[3] * hv[3]);
                    ss += __shfl_xor(ss, 16); ss += __shfl_xor(ss, 32);
                    if (fq == 0) unsafeAtomicAdd(partx + row, ss);
                }
            } else {
                f32x4 v2 = red[(8 * 4 + mt) * 64 + lane];
#pragma unroll
                for (int ww = 1; ww < 8; ++ww) v2 += red[((8 + ww) * 4 + mt) * 64 + lane];
                const u32x2 ga = *(const u32x2*)(U + (size_t)row * UW + U_GA + col), gb = *(const u32x2*)(U + (size_t)row * UW + U_GB + col);
                const f32x4 ba = *(const f32x4*)(gbias + col), bb = *(const f32x4*)(gbias + DM + col);
                f32x4 m;
                m[0] = sigmoidf_(bflo(ga.x) + ba[0]) * v[0] + sigmoidf_(bflo(gb.x) + bb[0]) * v2[0];
                m[1] = sigmoidf_(bfhi(ga.x) + ba[1]) * v[1] + sigmoidf_(bfhi(gb.x) + bb[1]) * v2[1];
                m[2] = sigmoidf_(bflo(ga.y) + ba[2]) * v[2] + sigmoidf_(bflo(gb.y) + bb[2]) * v2[2];
                m[3] = sigmoidf_(bfhi(ga.y) + ba[3]) * v[3] + sigmoidf_(bfhi(gb.y) + bb[3]) * v2[3];
                *(u32x2*)(outb + (size_t)row * DM + col) = pack4(m);
            }
        }
    }
    if constexpr (MODE == 15) {
        const int nblk = gridDim.x < 128 ? (int)gridDim.x : 128;
        if ((int)blockIdx.x < nblk) {
            asm volatile("s_waitcnt vmcnt(0)" ::: "memory");
            __syncthreads();
            volatile unsigned& last_flag = *(volatile unsigned*)(smem + 131072 + 8);
            if (tid == 0) {
                __builtin_amdgcn_fence(__ATOMIC_RELEASE, "agent");
                asm volatile("s_waitcnt vmcnt(0)" ::: "memory");
                const unsigned old = __hip_atomic_fetch_add(cnt, 1u, __ATOMIC_RELAXED, __HIP_MEMORY_SCOPE_AGENT);
                last_flag = (old + 1u == (unsigned)nblk) ? 1u : 0u;
                if (last_flag) { __builtin_amdgcn_fence(__ATOMIC_ACQUIRE, "agent"); asm volatile("s_waitcnt vmcnt(0)" ::: "memory"); }
            }
            __syncthreads();
            if (last_flag) {
                for (int r = w; r < 32; r += 8) {
                    const float* src = hx + (size_t)(R_SAMP - NPR + r) * DM; float* dst = ys + (size_t)r * DM;
                    const float ssq = __hip_atomic_load(partx + R_SAMP + r, __ATOMIC_RELAXED, __HIP_MEMORY_SCOPE_AGENT);
                    const float rs = rsqrtf(ssq * (1.f / 2048.f) + EPSV);
#pragma unroll
                    for (int j = 0; j < 8; ++j) {
                        f32x4 v;
                        v[0] = __hip_atomic_load(src + 4 * (lane + 64 * j) + 0, __ATOMIC_RELAXED, __HIP_MEMORY_SCOPE_AGENT); v[1] = __hip_atomic_load(src + 4 * (lane + 64 * j) + 1, __ATOMIC_RELAXED, __HIP_MEMORY_SCOPE_AGENT);
                        v[2] = __hip_atomic_load(src + 4 * (lane + 64 * j) + 2, __ATOMIC_RELAXED, __HIP_MEMORY_SCOPE_AGENT); v[3] = __hip_atomic_load(src + 4 * (lane + 64 * j) + 3, __ATOMIC_RELAXED, __HIP_MEMORY_SCOPE_AGENT);
                        ((f32x4*)dst)[lane + 64 * j] = v * rs * ((const f32x4*)fnorm)[lane + 64 * j];
                    }
                }
            }
        }
    }
    __syncthreads();
}

__device__ __forceinline__ int srccol_rt(int kind, int np) {
    if (kind == 0) return np;
    if (kind == 1) { const int g = np >> 5, n = (np >> 4) & 1, i = np & 15; return n * FF + 16 * g + i; }
    if (np < 3072) return np; if (np < 8704) return np + 16; if (np < 8720) return 3072 + (np - 8704); return -1;
}
struct TrDesc { const float* W; bf16_t* WT; int K, N, nnb, kind, idx; };
constexpr int IT_PRE_END = 2528, IT_1OUT_END = 3232, IT_MIX_END = 3744, IT_2IN_SPLIT = 4096, IT_2IN_END = 5152, IT_END = 5856;
__device__ __forceinline__ bool tr_decode(const Params& p, int it, int hi, TrDesc& d) {
    if (it >= hi) return false;
    unsigned char* ws = p.ws; int r = it;
    if (r < 1408) { d = TrDesc{p.in[9], (bf16_t*)(ws + WS_BT1IN), 2048, 11264, 44, 1, r}; return true; } r -= 1408;
    if (r < 1120) { d = TrDesc{p.in[12], (bf16_t*)(ws + WS_BTIN), 2048, 8720, 35, 2, r}; return true; } r -= 1120;
    if (r < 704) { d = TrDesc{p.in[10], (bf16_t*)(ws + WS_BT1OUT), 5632, 2048, 8, 0, r}; return true; } r -= 704;
    if (r < 128) { d = TrDesc{p.in[16], (bf16_t*)(ws + WS_BTGO), 1024, 2048, 8, 0, r}; return true; } r -= 128;
    if (r < 128) { d = TrDesc{p.in[18], (bf16_t*)(ws + WS_BTSO), 1024, 2048, 8, 0, r}; return true; } r -= 128;
    if (r < 256) { d = TrDesc{p.in[20], (bf16_t*)(ws + WS_BTOUT), 2048, 2048, 8, 0, r}; return true; } r -= 256;
    if (r < 1408) { d = TrDesc{p.in[22], (bf16_t*)(ws + WS_BT2IN), 2048, 11264, 44, 1, r}; return true; } r -= 1408;
    if (r < 704) { d = TrDesc{p.in[23], (bf16_t*)(ws + WS_BT2OUT), 5632, 2048, 8, 0, r}; return true; }
    return false;
}
__device__ __forceinline__ void tr_load(const TrDesc& d, int tid, f32x4 (&v)[8]) {
    const int kb = d.idx / d.nnb, nb = d.idx - kb * d.nnb, col4 = tid & 63, krow = tid >> 6;
    const int c = srccol_rt(d.kind, nb * 256 + 4 * col4);
    const float* src = d.W + (size_t)(kb * 64 + krow) * d.N + (c >= 0 ? c : 0);
#pragma unroll
    for (int i = 0; i < 8; ++i) v[i] = (c >= 0) ? *(const f32x4*)(src + (size_t)(8 * i) * d.N) : (f32x4){0.f, 0.f, 0.f, 0.f};
}
__device__ __forceinline__ void convert_items(const Params& p, unsigned char* smem, int lo, int hi, int first, int stride) {
    const int tid = threadIdx.x;
    float* tile = (float*)smem;
    int it = lo + first; TrDesc d; bool has = tr_decode(p, it, hi, d); f32x4 v[8];
    if (has) tr_load(d, tid, v);
    const int col4 = tid & 63, krow = tid >> 6, c8 = tid & 7;
    __syncthreads();
    while (has) {
#pragma unroll
        for (int i = 0; i < 8; ++i) { const int kk = krow + 8 * i; *(f32x4*)(tile + kk * 256 + 4 * (col4 ^ ((kk >> 3) & 7))) = v[i]; }
        TrDesc dn; const bool hn = tr_decode(p, it + stride, hi, dn);
        __syncthreads();
        if (hn) tr_load(dn, tid, v);
        const int kb = d.idx / d.nnb, nb = d.idx - kb * d.nnb;
#pragma unroll
        for (int j = 0; j < 4; ++j) {
            const int n = (tid >> 3) + 64 * j; const float* s = tile + (8 * c8) * 256 + 4 * ((n >> 2) ^ c8) + (n & 3);
            u32x4 o; o.x = cvt_pk_bf16(s[0 * 256], s[1 * 256]); o.y = cvt_pk_bf16(s[2 * 256], s[3 * 256]); o.z = cvt_pk_bf16(s[4 * 256], s[5 * 256]); o.w = cvt_pk_bf16(s[6 * 256], s[7 * 256]);
            *(u32x4*)(d.WT + (size_t)(nb * 256 + n) * d.K + kb * 64 + 8 * c8) = o;
        }
        __syncthreads();
        d = dn; has = hn; it += stride;
    }
}
__device__ __forceinline__ void convert_in_tail(const Params& p, unsigned char* smem, int nunits, int lo, int hi) {
    const int G = gridDim.x, extra = nunits % G, bid = blockIdx.x;
    if (extra == 0) convert_items(p, smem, lo, hi, bid, G);
    else if (bid >= extra) convert_items(p, smem, lo, hi, bid - extra, G - extra);
}
__device__ __forceinline__ void phase_pre(const Params& p, unsigned char* smem) {
    const int tid = threadIdx.x, lane = tid & 63, wave = tid >> 6, G = gridDim.x;
    convert_items(p, smem, 0, IT_PRE_END, blockIdx.x, G);
    const int gw = blockIdx.x * 8 + wave, NGW = G * 8;
    unsigned char* ws = p.ws;
    const float* g1 = p.in[8];
    bf16_t* A = (bf16_t*)(ws + WS_A); float* part = (float*)(ws + WS_PART); float* hx = (float*)(ws + WS_HX);
    for (int r = gw; r < RT; r += NGW) {
        const float* src = r < NPR ? p.in[0] + (size_t)r * DM : r < R_SAMP ? p.in[7] + (size_t)(r - R_META) * DM : r < R_SAMP + 32 ? p.in[1] + (size_t)(r - R_SAMP) * DM : nullptr;
        f32x4 v[8]; float s = 0.f;
#pragma unroll
        for (int j = 0; j < 8; ++j) { v[j] = src ? ((const f32x4*)src)[lane + 64 * j] : (f32x4){0.f, 0.f, 0.f, 0.f}; s += (v[j][0] * v[j][0] + v[j][1] * v[j][1]) + (v[j][2] * v[j][2] + v[j][3] * v[j][3]); }
        const float tot = wave_sum(s);
#pragma unroll
        for (int j = 0; j < 8; ++j) { if (r >= NPR) ((f32x4*)(hx + (size_t)(r - NPR) * DM))[lane + 64 * j] = v[j]; const f32x4 g = ((const f32x4*)g1)[lane + 64 * j];
            *(u32x2*)(A + (size_t)r * DM + 4 * (lane + 64 * j)) = pack4(v[j] * g); }
        if (lane < 4) part[(size_t)lane * RT + r] = (lane == 0) ? tot : 0.f;
    }
}

__device__ __forceinline__ void gla_prep_item(const Params& p, unsigned char* smem, int item) {
    const int tid = threadIdx.x, lane = tid & 63, w = tid >> 6, fr = lane & 15, fq = lane >> 4;
    const int b = item >> 7, h = (item >> 5) & 3, c = item & 31, row0 = b * 2048 + 64 * c;
    float* Bc = (float*)smem;
    bf16_t* Qt = (bf16_t*)(smem + 32768);
    bf16_t* Kt = Qt + 64 * 136;
    float* GAD = (float*)(Kt + 64 * 136);
    float* TOT = GAD + 64 * 16;
    const bf16_t* U = (const bf16_t*)(p.ws + WS_UH);
    bf16_t* QTw = (bf16_t*)(p.ws + WS_QT) + (size_t)item * 8192;
    bf16_t* KHw = (bf16_t*)(p.ws + WS_KH) + (size_t)item * 8192;
    bf16_t* ATw = (bf16_t*)(p.ws + WS_ATT) + (size_t)item * 4096;
    float* DECw = (float*)(p.ws + WS_DEC) + (size_t)item * 128;
    const int d1 = tid & 127, tg = tid >> 7, t8 = tid >> 3, p8 = tid & 7;
    float aup[16];
#pragma unroll
    for (int r = 0; r < 16; ++r) aup[r] = p.in[13][r * 512 + h * 128 + d1];
    const float bias1 = p.in[14][h * 128 + d1];
    __syncthreads();
    {
        const unsigned gw = *(const unsigned*)(U + (size_t)(row0 + t8) * UW + U_GAD + 2 * p8);
        GAD[t8 * 16 + 2 * p8] = bflo(gw); GAD[t8 * 16 + 2 * p8 + 1] = bfhi(gw);
    }
    float kc[16];
#pragma unroll
    for (int i = 0; i < 16; ++i) kc[i] = bf2f(U[(size_t)(row0 + tg * 16 + i) * UW + U_GK + h * 128 + d1]);
    __syncthreads();
    float bl[16]; float run = 0.f;
#pragma unroll
    for (int i = 0; i < 16; ++i) { const int t = tg * 16 + i; float x = bias1;
#pragma unroll
        for (int r = 0; r < 16; ++r) x += GAD[t * 16 + r] * aup[r];
        run += logsigf_(x) * (1.f / 16.f); bl[i] = run; }
    TOT[tg * 128 + d1] = run;
    __syncthreads();
    {
        float pre = 0.f, blast = 0.f;
#pragma unroll
        for (int g = 0; g < 4; ++g) { const float tv = TOT[g * 128 + d1]; blast += tv; if (g < tg) pre += tv; }
        float kh[16];
#pragma unroll
        for (int i = 0; i < 16; ++i) { bl[i] += pre; Bc[(tg * 16 + i) * 128 + d1] = bl[i]; kh[i] = kc[i] * __expf(blast - bl[i]); }
        u32x4 o0, o1;
        o0.x = cvt_pk_bf16(kh[0], kh[1]); o0.y = cvt_pk_bf16(kh[2], kh[3]); o0.z = cvt_pk_bf16(kh[4], kh[5]); o0.w = cvt_pk_bf16(kh[6], kh[7]);
        o1.x = cvt_pk_bf16(kh[8], kh[9]); o1.y = cvt_pk_bf16(kh[10], kh[11]); o1.z = cvt_pk_bf16(kh[12], kh[13]); o1.w = cvt_pk_bf16(kh[14], kh[15]);
        *(u32x4*)(KHw + d1 * 64 + tg * 16) = o0; *(u32x4*)(KHw + d1 * 64 + tg * 16 + 8) = o1;
        if (tg == 0) DECw[d1] = __expf(blast);
    }
    __syncthreads();
    {
        const int d0 = p8 * 16; const bf16_t* ur = U + (size_t)(row0 + t8) * UW + h * 128 + d0;
        const u32x4 q0 = *(const u32x4*)(ur + U_GQ), q1 = *(const u32x4*)(ur + U_GQ + 8), k0 = *(const u32x4*)(ur + U_GK), k1 = *(const u32x4*)(ur + U_GK + 8);
        const unsigned qw[8] = {q0.x, q0.y, q0.z, q0.w, q1.x, q1.y, q1.z, q1.w}, kw[8] = {k0.x, k0.y, k0.z, k0.w, k1.x, k1.y, k1.z, k1.w};
        unsigned qo[8], ko[8];
#pragma unroll
        for (int e = 0; e < 8; ++e) {
            const float b0 = Bc[t8 * 128 + d0 + 2 * e], b1 = Bc[t8 * 128 + d0 + 2 * e + 1];
            qo[e] = cvt_pk_bf16(bflo(qw[e]) * 0.08838834764831845f * __expf(b0), bfhi(qw[e]) * 0.08838834764831845f * __expf(b1));
            ko[e] = cvt_pk_bf16(bflo(kw[e]) * __expf(-b0), bfhi(kw[e]) * __expf(-b1));
        }
        const u32x4 qa = {qo[0], qo[1], qo[2], qo[3]}, qb = {qo[4], qo[5], qo[6], qo[7]};
        *(u32x4*)(Qt + t8 * 136 + d0) = qa; *(u32x4*)(Qt + t8 * 136 + d0 + 8) = qb;
        *(u32x4*)(QTw + t8 * 128 + d0) = qa; *(u32x4*)(QTw + t8 * 128 + d0 + 8) = qb;
        *(u32x4*)(Kt + t8 * 136 + d0) = (u32x4){ko[0], ko[1], ko[2], ko[3]}; *(u32x4*)(Kt + t8 * 136 + d0 + 8) = (u32x4){ko[4], ko[5], ko[6], ko[7]};
    }
    __syncthreads();
    {
        const int tt = w >> 1;
#pragma unroll
        for (int si = 0; si < 2; ++si) {
            const int st = 2 * (w & 1) + si; f32x4 acc = {0.f, 0.f, 0.f, 0.f};
            if (st <= tt) {
#pragma unroll
                for (int kk = 0; kk < 4; ++kk) {
                    const bf16x8 a = *(const bf16x8*)(Kt + (16 * st + fr) * 136 + 8 * fq + 32 * kk);
                    const bf16x8 bq = *(const bf16x8*)(Qt + (16 * tt + fr) * 136 + 8 * fq + 32 * kk);
                    acc = mfma16(a, bq, acc);
                }
                if (st == tt) {
#pragma unroll
                    for (int r = 0; r < 4; ++r) if (4 * fq + r > fr) acc[r] = 0.f;
                }
            }
            *(u32x2*)(ATw + (16 * tt + fr) * 64 + 16 * st + 4 * fq) = pack4c(acc);
        }
    }
}

__device__ __forceinline__ void gla_scan_unit(const Params& p, unsigned char* smem, int unit) {
    const int tid = threadIdx.x, lane = tid & 63, w = tid >> 6, fr = lane & 15, fq = lane >> 4;
    const int b = unit >> 5, h = (unit >> 3) & 3, dvs = unit & 7;
    float* Bc = (float*)smem;
    bf16_t* KhT = (bf16_t*)(smem + 32768);
    bf16_t* VT = KhT + 128 * 72;
    bf16_t* ST = VT + 2 * 32 * 72;
    float* GAD = (float*)(ST + 2 * 32 * 136);
    float* TOT = GAD + 64 * 16;
    const bf16_t* U = (const bf16_t*)(p.ws + WS_UH);
    bf16_t* Og = (bf16_t*)(p.ws + WS_OG);
    const int d1 = tid & 127, tg = tid >> 7, t8 = tid >> 3, p8 = tid & 7;
    f32x4 Sacc[2] = {(f32x4){0.f, 0.f, 0.f, 0.f}, (f32x4){0.f, 0.f, 0.f, 0.f}};
    const int vcol = U_GV + h * 256 + dvs * 32 + 4 * p8;
    __syncthreads();
    {
        float aup[16];
#pragma unroll
        for (int r = 0; r < 16; ++r) aup[r] = p.in[13][r * 512 + h * 128 + d1];
        const float bias1 = p.in[14][h * 128 + d1];
        {
            const bool ok = t8 < 16; const bf16_t* ur = U + (size_t)(R_META + (ok ? t8 : 0)) * UW;
            const unsigned gw = ok ? *(const unsigned*)(ur + U_GAD + 2 * p8) : 0u;
            GAD[t8 * 16 + 2 * p8] = bflo(gw); GAD[t8 * 16 + 2 * p8 + 1] = bfhi(gw);
            const u32x2 vw = ok ? *(const u32x2*)(ur + vcol) : (u32x2){0u, 0u};
            VT[(4 * p8 + 0) * 72 + t8] = (bf16_t)(vw.x & 0xffffu); VT[(4 * p8 + 1) * 72 + t8] = (bf16_t)(vw.x >> 16);
            VT[(4 * p8 + 2) * 72 + t8] = (bf16_t)(vw.y & 0xffffu); VT[(4 * p8 + 3) * 72 + t8] = (bf16_t)(vw.y >> 16);
        }
        float kc[16];
#pragma unroll
        for (int i = 0; i < 16; ++i) kc[i] = (tg == 0) ? bf2f(U[(size_t)(R_META + i) * UW + U_GK + h * 128 + d1]) : 0.f;
        __syncthreads();
        float bl[16]; float run = 0.f;
#pragma unroll
        for (int i = 0; i < 16; ++i) { const int t = tg * 16 + i; float x = bias1;
#pragma unroll
            for (int r = 0; r < 16; ++r) x += GAD[t * 16 + r] * aup[r];
            const float lg = (tg == 0) ? logsigf_(x) * (1.f / 16.f) : 0.f; run += lg; bl[i] = run; }
        TOT[tg * 128 + d1] = run;
        __syncthreads();
        {
            float pre = 0.f, blast = 0.f;
#pragma unroll
            for (int g = 0; g < 4; ++g) { const float tv = TOT[g * 128 + d1]; blast += tv; if (g < tg) pre += tv; }
            float kh[16];
#pragma unroll
            for (int i = 0; i < 16; ++i) { bl[i] += pre; kh[i] = kc[i] * __expf(blast - bl[i]); }
            if (tg == 0) Bc[d1] = blast;
            u32x4 o0, o1;
            o0.x = cvt_pk_bf16(kh[0], kh[1]); o0.y = cvt_pk_bf16(kh[2], kh[3]); o0.z = cvt_pk_bf16(kh[4], kh[5]); o0.w = cvt_pk_bf16(kh[6], kh[7]);
            o1.x = cvt_pk_bf16(kh[8], kh[9]); o1.y = cvt_pk_bf16(kh[10], kh[11]); o1.z = cvt_pk_bf16(kh[12], kh[13]); o1.w = cvt_pk_bf16(kh[14], kh[15]);
            *(u32x4*)(KhT + d1 * 72 + tg * 16) = o0; *(u32x4*)(KhT + d1 * 72 + tg * 16 + 8) = o1;
        }
        __syncthreads();
#pragma unroll
        for (int dvt = 0; dvt < 2; ++dvt) {
            f32x4 nw = {0.f, 0.f, 0.f, 0.f};
#pragma unroll
            for (int kk = 0; kk < 2; ++kk) {
                const bf16x8 a = *(const bf16x8*)(KhT + (16 * w + fr) * 72 + 8 * fq + 32 * kk);
                const bf16x8 bb = *(const bf16x8*)(VT + (16 * dvt + fr) * 72 + 8 * fq + 32 * kk);
                nw = mfma16(a, bb, nw);
            }
            Sacc[dvt] = nw;
        }
    }
    const size_t item0 = (size_t)((b * 4 + h) * 32);
    const bf16_t* QTw = (const bf16_t*)(p.ws + WS_QT) + item0 * 8192 + (16 * (w >> 1) + fr) * 128 + 8 * fq;
    const bf16_t* ATw = (const bf16_t*)(p.ws + WS_ATT) + item0 * 4096 + (16 * (w >> 1) + fr) * 64 + 8 * fq;
    const bf16_t* KHw = (const bf16_t*)(p.ws + WS_KH) + item0 * 8192 + (16 * w + fr) * 64 + 8 * fq;
    const float* DECw = (const float*)(p.ws + WS_DEC) + item0 * 128 + 16 * w + 4 * fq;
    const bf16_t* Vg = U + (size_t)(b * 2048 + t8) * UW + vcol;
    struct Ops { bf16x8 q[4], a[2], kh[2]; f32x4 dec; u32x2 v; };
    Ops r0, r1, r2;
#define GLA_LOAD(R, cc) do { const int c_ = (cc) < 32 ? (cc) : 31; \
        _Pragma("unroll") for (int kk = 0; kk < 4; ++kk) R.q[kk] = *(const bf16x8*)(QTw + (size_t)c_ * 8192 + 32 * kk); \
        _Pragma("unroll") for (int kk = 0; kk < 2; ++kk) { R.a[kk] = *(const bf16x8*)(ATw + (size_t)c_ * 4096 + 32 * kk); R.kh[kk] = *(const bf16x8*)(KHw + (size_t)c_ * 8192 + 32 * kk); } \
        R.dec = *(const f32x4*)(DECw + c_ * 128); R.v = *(const u32x2*)(Vg + (size_t)(64 * c_) * UW); } while (0)
    GLA_LOAD(r0, 0); GLA_LOAD(r1, 1);
    __syncthreads();
#pragma unroll
    for (int dvt = 0; dvt < 2; ++dvt) *(u32x2*)(ST + (16 * dvt + fr) * 136 + 16 * w + 4 * fq) = pack4c(Sacc[dvt]);
    VT[(4 * p8 + 0) * 72 + t8] = (bf16_t)(r0.v.x & 0xffffu); VT[(4 * p8 + 1) * 72 + t8] = (bf16_t)(r0.v.x >> 16);
    VT[(4 * p8 + 2) * 72 + t8] = (bf16_t)(r0.v.y & 0xffffu); VT[(4 * p8 + 3) * 72 + t8] = (bf16_t)(r0.v.y >> 16);
#define GLA_BODY(cc, CUR, NX1, FAR) do { const int c = (cc); \
        GLA_LOAD(FAR, c + 2); \
        asm volatile("s_waitcnt lgkmcnt(0)" ::: "memory"); __builtin_amdgcn_s_barrier(); asm volatile("" ::: "memory"); \
        const bf16_t* vt = VT + (c & 1) * (32 * 72); const bf16_t* st = ST + (c & 1) * (32 * 136); \
        { const int tt = w >> 1, dvt = w & 1; f32x4 acc = {0.f, 0.f, 0.f, 0.f}, acc2 = {0.f, 0.f, 0.f, 0.f}; \
          const bf16x8 lv0 = *(const bf16x8*)(vt + (16 * dvt + fr) * 72 + 8 * fq), lv1 = *(const bf16x8*)(vt + (16 * dvt + fr) * 72 + 8 * fq + 32); \
          const bf16x8 ls0 = *(const bf16x8*)(st + (16 * dvt + fr) * 136 + 8 * fq), ls1 = *(const bf16x8*)(st + (16 * dvt + fr) * 136 + 8 * fq + 32), \
                       ls2 = *(const bf16x8*)(st + (16 * dvt + fr) * 136 + 8 * fq + 64), ls3 = *(const bf16x8*)(st + (16 * dvt + fr) * 136 + 8 * fq + 96); \
          __builtin_amdgcn_sched_barrier(0); \
          acc = mfma16(lv0, CUR.a[0], acc); acc2 = mfma16(ls0, CUR.q[0], acc2); acc = mfma16(lv1, CUR.a[1], acc); acc2 = mfma16(ls1, CUR.q[1], acc2); \
          acc = mfma16(ls2, CUR.q[2], acc); acc2 = mfma16(ls3, CUR.q[3], acc2); acc = acc + acc2; \
          *(u32x2*)(Og + (size_t)(b * 2048 + 64 * c + 16 * tt + fr) * 1024 + h * 256 + dvs * 32 + 16 * dvt + 4 * fq) = pack4c(acc); } \
        bf16_t* stn = ST + ((c + 1) & 1) * (32 * 136); bf16_t* vtn = VT + ((c + 1) & 1) * (32 * 72); \
        _Pragma("unroll") for (int dvt = 0; dvt < 2; ++dvt) { f32x4 nw = {0.f, 0.f, 0.f, 0.f}; \
          _Pragma("unroll") for (int kk = 0; kk < 2; ++kk) nw = mfma16(CUR.kh[kk], *(const bf16x8*)(vt + (16 * dvt + fr) * 72 + 8 * fq + 32 * kk), nw); \
          Sacc[dvt] = Sacc[dvt] * CUR.dec + nw; \
          *(u32x2*)(stn + (16 * dvt + fr) * 136 + 16 * w + 4 * fq) = pack4c(Sacc[dvt]); } \
        vtn[(4 * p8 + 0) * 72 + t8] = (bf16_t)(NX1.v.x & 0xffffu); vtn[(4 * p8 + 1) * 72 + t8] = (bf16_t)(NX1.v.x >> 16); \
        vtn[(4 * p8 + 2) * 72 + t8] = (bf16_t)(NX1.v.y & 0xffffu); vtn[(4 * p8 + 3) * 72 + t8] = (bf16_t)(NX1.v.y >> 16); } while (0)
    for (int c3 = 0; c3 < 30; c3 += 3) {
        GLA_BODY(c3, r0, r1, r2);
        GLA_BODY(c3 + 1, r1, r2, r0);
        GLA_BODY(c3 + 2, r2, r0, r1);
    }
    GLA_BODY(30, r0, r1, r2);
    GLA_BODY(31, r1, r2, r0);
#undef GLA_BODY
#undef GLA_LOAD
    float* pg = p.out + O_PGLA + (size_t)((b * 4 + h) * 128) * 256 + dvs * 32;
#pragma unroll
    for (int dvt = 0; dvt < 2; ++dvt)
#pragma unroll
        for (int r = 0; r < 4; ++r) pg[(size_t)(16 * w + 4 * fq + r) * 256 + 16 * dvt + fr] = Sacc[dvt][r];
    __syncthreads();
}

__device__ __forceinline__ void swa_prompt_unit(const Params& p, unsigned char* smem, int unit) {
    const int tid = threadIdx.x, lane = tid & 63, w = tid >> 6, fr = lane & 15, fq = lane >> 4;
    const int b = unit >> 6, kvh = (unit >> 4) & 3, n = unit & 15;
    bf16_t* Ks = (bf16_t*)smem;
    bf16_t* VT = Ks + 272 * 72;
    const bf16_t* U = (const bf16_t*)(p.ws + WS_UH);
    bf16_t* O = (bf16_t*)(p.ws + WS_O);
    __syncthreads();
    {
        u32x4 kv[5], vv[5];
#pragma unroll
        for (int it = 0; it < 5; ++it) {
            const int idx = tid + 512 * it; const int sl = idx >> 3, c8 = idx & 7;
            int row; bool ok = idx < 272 * 8;
            if (sl < 16) row = R_META + sl; else { const int pos = n * 128 + (sl - 16) - 128; ok = ok && pos >= 0; row = b * 2048 + pos; }
            kv[it] = (u32x4){0u, 0u, 0u, 0u}; vv[it] = (u32x4){0u, 0u, 0u, 0u};
            if (ok) { const bf16_t* ur = U + (size_t)row * UW + kvh * 64 + 8 * c8; kv[it] = *(const u32x4*)(ur + U_SK); vv[it] = *(const u32x4*)(ur + U_SV); }
        }
#pragma unroll
        for (int it = 0; it < 5; ++it) {
            const int idx = tid + 512 * it; const int sl = idx >> 3, c8 = idx & 7;
            if (idx < 272 * 8) {
                *(u32x4*)(Ks + sl * 72 + 8 * c8) = kv[it];
                bf16_t* vt = VT + (8 * c8) * 280 + sl; const u32x4 v4 = vv[it];
                vt[0 * 280] = (bf16_t)(v4.x & 0xffffu); vt[1 * 280] = (bf16_t)(v4.x >> 16); vt[2 * 280] = (bf16_t)(v4.y & 0xffffu); vt[3 * 280] = (bf16_t)(v4.y >> 16);
                vt[4 * 280] = (bf16_t)(v4.z & 0xffffu); vt[5 * 280] = (bf16_t)(v4.z >> 16); vt[6 * 280] = (bf16_t)(v4.w & 0xffffu); vt[7 * 280] = (bf16_t)(v4.w >> 16);
            }
        }
    }
    __syncthreads();
    const int qt = w;
    bf16x8 qall[4][2];
#pragma unroll
    for (int g = 0; g < 4; ++g) { const bf16_t* qp0 = U + (size_t)(b * 2048 + n * 128 + 16 * qt + fr) * UW + U_SQ + (kvh * 4 + g) * 64 + 8 * fq; qall[g][0] = *(const bf16x8*)qp0; qall[g][1] = *(const bf16x8*)(qp0 + 32); }
#pragma unroll
    for (int g = 0; g < 4; ++g) {
        const int head = kvh * 4 + g;
        const float slope = exp2f(-0.5f * (float)(head + 1)), sink = p.in[17][head];
        const int qrow = b * 2048 + n * 128 + 16 * qt + fr;
        const bf16x8 qf0 = qall[g][0], qf1 = qall[g][1];
        f32x4 sc[10];
        float mx = -1e30f;
#pragma unroll
        for (int T = 0; T < 10; ++T) {
            const int slot0 = (T == 0) ? 0 : 16 + 16 * (qt + T - 1);
            f32x4 acc = {0.f, 0.f, 0.f, 0.f};
            acc = mfma16(*(const bf16x8*)(Ks + (slot0 + fr) * 72 + 8 * fq), qf0, acc);
            acc = mfma16(*(const bf16x8*)(Ks + (slot0 + fr) * 72 + 8 * fq + 32), qf1, acc);
#pragma unroll
            for (int r = 0; r < 4; ++r) {
                float s = acc[r] * 0.125f;
                if (T > 0) {
                    const int j = 16 * (qt + T - 1) + 4 * fq + r, i = 16 * qt + fr, dist = i + 128 - j;
                    const bool valid = (dist >= 0) && (dist < 128) && (n * 128 + j - 128 >= 0);
                    s = valid ? s - slope * (float)dist : -1e30f;
                }
                acc[r] = s; mx = fmaxf(mx, s);
            }
            sc[T] = acc;
        }
        mx = fmaxf(mx, __shfl_xor(mx, 16)); mx = fmaxf(mx, __shfl_xor(mx, 32)); mx = fmaxf(mx, sink);
        float sum = 0.f;
#pragma unroll
        for (int T = 0; T < 10; ++T)
#pragma unroll
            for (int r = 0; r < 4; ++r) { const float e = __expf(sc[T][r] - mx); sc[T][r] = e; sum += e; }
        sum += __shfl_xor(sum, 16); sum += __shfl_xor(sum, 32);
        const float inv = 1.f / (sum + __expf(sink - mx));
        f32x4 oacc[4] = {(f32x4){0.f, 0.f, 0.f, 0.f}, (f32x4){0.f, 0.f, 0.f, 0.f}, (f32x4){0.f, 0.f, 0.f, 0.f}, (f32x4){0.f, 0.f, 0.f, 0.f}};
#pragma unroll
        for (int pp = 0; pp < 5; ++pp) {
            const int T0 = 2 * pp, T1 = 2 * pp + 1;
            const int s0 = (T0 == 0) ? 0 : 16 + 16 * (qt + T0 - 1), s1 = 16 + 16 * (qt + T1 - 1);
            const u32x2 pa = pack4(sc[T0]), pb = pack4(sc[T1]);
            const u32x4 pw = {pa.x, pa.y, pb.x, pb.y};
            bf16x8 pf; __builtin_memcpy(&pf, &pw, 16);
#pragma unroll
            for (int dvt = 0; dvt < 4; ++dvt) {
                const u32x2 va = *(const u32x2*)(VT + (16 * dvt + fr) * 280 + s0 + 4 * fq), vb = *(const u32x2*)(VT + (16 * dvt + fr) * 280 + s1 + 4 * fq);
                const u32x4 vw = {va.x, va.y, vb.x, vb.y};
                bf16x8 vf; __builtin_memcpy(&vf, &vw, 16);
                oacc[dvt] = mfma16(vf, pf, oacc[dvt]);
            }
        }
#pragma unroll
        for (int dvt = 0; dvt < 4; ++dvt) *(u32x2*)(O + (size_t)qrow * 1024 + head * 64 + 16 * dvt + 4 * fq) = pack4(oacc[dvt] * inv);
    }
    __syncthreads();
}

__device__ __forceinline__ float gla_state_step(const float* __restrict__ s0p, float* __restrict__ snp, const float* eg, const float* kk, const float* qt, float v, int dbeg) {
    float op = 0.f;
#pragma unroll 8
    for (int d = dbeg; d < dbeg + 64; ++d) { const float s0 = s0p[(size_t)d * 256]; snp[(size_t)d * 256] = s0 * eg[d] + kk[d] * v; op += qt[d] * s0; }
    return op;
}
__device__ __forceinline__ void gla_sample_unit(const Params& p, unsigned char* smem, int unit) {
    const int tid = threadIdx.x; const int i = unit >> 2, h = unit & 3, row = R_SAMP + i;
    float* eg = (float*)smem; float* qt = eg + 128; float* kk = qt + 128; float* vv = kk + 128; float* red = vv + 256; float* red2 = red + 128;
    const bf16_t* ur = (const bf16_t*)(p.ws + WS_UH) + (size_t)row * UW;
    bf16_t* Og = (bf16_t*)(p.ws + WS_OG);
    __syncthreads();
    if (tid < 128) {
        const int d = tid; float x = p.in[14][h * 128 + d];
#pragma unroll
        for (int r = 0; r < 16; ++r) x += bf2f(ur[U_GAD + r]) * p.in[13][r * 512 + h * 128 + d];
        const float lg = logsigf_(x) * (1.f / 16.f), e = __expf(lg);
        const float q = bf2f(ur[U_GQ + h * 128 + d]) * 0.08838834764831845f, k = bf2f(ur[U_GK + h * 128 + d]);
        eg[d] = e; qt[d] = q * e; kk[d] = k; red[d] = q * k;
    } else if (tid < 384) { const int dv = tid - 128; vv[dv] = bf2f(ur[U_GV + h * 256 + dv]); }
    __syncthreads();
    float qk = 0.f;
    for (int d = 0; d < 128; ++d) qk += red[d];
    const int dv = tid & 255, half = tid >> 8;
    const float* s0p = p.in[6] + (size_t)((i * 4 + h) * 128) * 256 + dv;
    float* snp = p.out + O_SGLA + (size_t)((i * 4 + h) * 128) * 256 + dv;
    const float v = vv[dv]; const float op = gla_state_step(s0p, snp, eg, kk, qt, v, half * 64);
    red2[tid] = op;
    __syncthreads();
    if (half == 0) { const float o = red2[tid] + red2[tid + 256] + qk * v; Og[(size_t)row * 1024 + h * 256 + dv] = f2bf(o); }
    __syncthreads();
}

__device__ __forceinline__ void swa_sample_unit(const Params& p, unsigned char* smem, int unit) {
    const int tid = threadIdx.x, lane = tid & 63, w = tid >> 6; const int i = unit >> 2, kvh = unit & 3, row = R_SAMP + i;
    float* qv = (float*)smem; float* knew = qv + 256; float* vnew = knew + 64; float* sc = vnew + 64; float* invd = sc + 4 * 144; float* red2 = invd + 4;
    const bf16_t* ur = (const bf16_t*)(p.ws + WS_UH) + (size_t)row * UW;
    bf16_t* O = (bf16_t*)(p.ws + WS_O);
    const float* cmk = p.in[2]; const float* cmv = p.in[3]; const float* cwk = p.in[4]; const float* cwv = p.in[5];
    __syncthreads();
    if (tid < 256) qv[tid] = bf2f(ur[U_SQ + kvh * 256 + tid]) * 0.125f;
    else if (tid < 320) knew[tid - 256] = bf2f(ur[U_SK + kvh * 64 + (tid - 256)]);
    else if (tid < 384) vnew[tid - 320] = bf2f(ur[U_SV + kvh * 64 + (tid - 320)]);
    __syncthreads();
    for (int idx = tid; idx < 576; idx += 512) {
        const int g = idx / 144, key = idx % 144; const float slope = exp2f(-0.5f * (float)(kvh * 4 + g + 1));
        float s = 0.f, biasv = 0.f;
        if (key == 143) { for (int c = 0; c < 64; ++c) s += qv[g * 64 + c] * knew[c]; }
        else {
            const float* kp;
            if (key < 16) kp = cmk + (size_t)((i * 16 + key) * 4 + kvh) * 64;
            else { const int c = key - 15; kp = cwk + (size_t)((i * 128 + c) * 4 + kvh) * 64; biasv = slope * (float)(128 - c); }
#pragma unroll 4
            for (int c4 = 0; c4 < 16; ++c4) { const f32x4 kvv = ((const f32x4*)kp)[c4]; const float* q4 = qv + g * 64 + 4 * c4;
                s += (q4[0] * kvv[0] + q4[1] * kvv[1]) + (q4[2] * kvv[2] + q4[3] * kvv[3]); }
        }
        sc[g * 144 + key] = s - biasv;
    }
    __syncthreads();
    if (w < 4) {
        const int g = w; const float sink = p.in[17][kvh * 4 + g];
        float m = -1e30f;
        for (int key = lane; key < 144; key += 64) m = fmaxf(m, sc[g * 144 + key]);
        m = fmaxf(wave_max(m), sink);
        float sum = 0.f;
        for (int key = lane; key < 144; key += 64) { const float e = __expf(sc[g * 144 + key] - m); sc[g * 144 + key] = e; sum += e; }
        sum = wave_sum(sum);
        if (lane == 0) invd[g] = 1.f / (sum + __expf(sink - m));
    }
    __syncthreads();
    {
        const int g = (tid >> 6) & 3, dv = tid & 63, half = tid >> 8; float op = 0.f;
        const float* scg = sc + g * 144;
        if (half == 0) {
            const float* mv = cmv + (size_t)(i * 16 * 4 + kvh) * 64 + dv;
#pragma unroll
            for (int key = 0; key < 16; ++key) op += scg[key] * mv[(size_t)key * 256];
            const float* wv = cwv + (size_t)((i * 128 + 1) * 4 + kvh) * 64 + dv;
#pragma unroll 8
            for (int c = 0; c < 56; ++c) op += scg[16 + c] * wv[(size_t)c * 256];
        } else {
            const float* wv = cwv + (size_t)((i * 128 + 57) * 4 + kvh) * 64 + dv;
#pragma unroll 8
            for (int c = 0; c < 71; ++c) op += scg[72 + c] * wv[(size_t)c * 256];
            op += scg[143] * vnew[dv];
        }
        red2[tid] = op;
    }
    __syncthreads();
    if (tid < 256) { const int g = tid >> 6, dv = tid & 63; O[(size_t)row * 1024 + (kvh * 4 + g) * 64 + dv] = f2bf((red2[tid] + red2[tid + 256]) * invd[g]); }
    float* owk = p.out + O_SWK; float* owv = p.out + O_SWV;
    for (int ib = 0; ib < 16; ib += 8) {
        float kb[8], vb[8];
#pragma unroll
        for (int it = 0; it < 8; ++it) {
            const int idx = tid + 512 * (ib + it), c = idx >> 6, e = idx & 63;
            if (c < 127) { const size_t si = (size_t)((i * 128 + c + 1) * 4 + kvh) * 64 + e; kb[it] = cwk[si]; vb[it] = cwv[si]; }
            else { kb[it] = knew[e]; vb[it] = vnew[e]; }
        }
#pragma unroll
        for (int it = 0; it < 8; ++it) {
            const int idx = tid + 512 * (ib + it), c = idx >> 6, e = idx & 63; const size_t di = (size_t)((i * 128 + c) * 4 + kvh) * 64 + e;
            owk[di] = kb[it]; owv[di] = vb[it];
        }
    }
    __syncthreads();
}

__device__ __forceinline__ void phase_mixer_a(const Params& p, unsigned char* smem) {
    const int G = gridDim.x, bid = blockIdx.x;
    for (int u = bid; u < 512; u += G) gla_prep_item(p, smem, u);
}
__device__ __forceinline__ void phase_mixer_b(const Params& p, unsigned char* smem) {
    const int G = gridDim.x, bid = blockIdx.x;
    for (int u = bid; u < 128; u += G) gla_scan_unit(p, smem, ((u & 7) << 4) | (u >> 3));
    const bool split = G >= 256;
    if (split && bid < 128) return;
    const int vb = split ? bid - 128 : bid, nb = split ? G - 128 : G;
    for (int u = vb; u < 256; u += nb) swa_prompt_unit(p, smem, u);
    for (int u = vb; u < 128; u += nb) gla_sample_unit(p, smem, u);
    for (int u = vb; u < 128; u += nb) swa_sample_unit(p, smem, u);
}

__device__ __forceinline__ void phase_gnorm(const Params& p) {
    const int tid = threadIdx.x, lane = tid & 63, wave = tid >> 6;
    const int gw = blockIdx.x * 8 + wave, NGW = gridDim.x * 8;
    const bf16_t* U = (const bf16_t*)(p.ws + WS_UH); bf16_t* Og = (bf16_t*)(p.ws + WS_OG); const float* onorm = p.in[15];
    for (int ri = gw; ri < NPR + 32; ri += NGW) {
        const int row = ri < NPR ? ri : R_SAMP + (ri - NPR);
#pragma unroll
        for (int hh = 0; hh < 4; ++hh) {
            const int col = hh * 256 + 4 * lane;
            u32x2* op = (u32x2*)(Og + (size_t)row * 1024 + col);
            const u32x2 ow = *op; const u32x2 gw2 = *(const u32x2*)(U + (size_t)row * UW + U_GR + col);
            const f32x4 on = *(const f32x4*)(onorm + col);
            const float o0 = bflo(ow.x), o1 = bfhi(ow.x), o2 = bflo(ow.y), o3 = bfhi(ow.y);
            const float ss = wave_sum((o0 * o0 + o1 * o1) + (o2 * o2 + o3 * o3));
            const float rs = rsqrtf(ss * (1.f / 256.f) + EPSV);
            f32x4 v; v[0] = o0 * rs * on[0] * siluf_(bflo(gw2.x)); v[1] = o1 * rs * on[1] * siluf_(bfhi(gw2.x));
            v[2] = o2 * rs * on[2] * siluf_(bflo(gw2.y)); v[3] = o3 * rs * on[3] * siluf_(bfhi(gw2.y));
            *op = pack4(v);
        }
    }
    const int gt = blockIdx.x * 512 + tid, NT = gridDim.x * 512;
    for (int idx = gt; idx < 2 * 16384 + 2 * 131072; idx += NT) {
        if (idx < 32768) { const int which = idx >> 14, r = idx & 16383, m = (r >> 8) & 15, col = r & 255;
            p.out[(which ? O_PMV : O_PMK) + r] = bf2f(U[(size_t)(R_META + m) * UW + (which ? U_SV : U_SK) + col]); }
        else { const int r2 = idx - 32768, which = r2 >> 17, r = r2 & 131071, b = r >> 15, j = (r >> 8) & 127, col = r & 255;
            p.out[(which ? O_PWV : O_PWK) + r] = bf2f(U[(size_t)(b * 2048 + 1920 + j) * UW + (which ? U_SV : U_SK) + col]); }
    }
}

__device__ __forceinline__ void phase_final(const Params& p) {
    const int tid = threadIdx.x, lane = tid & 63, wave = tid >> 6;
    const int gw = blockIdx.x * 8 + wave, NGW = gridDim.x * 8;
    const float* fn = p.in[24]; const float* hx = (const float*)(p.ws + WS_HX);
    for (int ri = gw; ri < NPR + 32; ri += NGW) {
        const float* src = ri < NPR ? p.out + O_YP + (size_t)ri * DM : hx + (size_t)(R_SAMP - NPR + (ri - NPR)) * DM;
        float* dst = ri < NPR ? p.out + O_YP + (size_t)ri * DM : p.out + O_YS + (size_t)(ri - NPR) * DM;
        f32x4 v[8]; float s = 0.f;
#pragma unroll
        for (int j = 0; j < 8; ++j) { v[j] = ((const f32x4*)src)[lane + 64 * j]; s += (v[j][0] * v[j][0] + v[j][1] * v[j][1]) + (v[j][2] * v[j][2] + v[j][3] * v[j][3]); }
        const float rs = rsqrtf(wave_sum(s) * (1.f / 2048.f) + EPSV);
#pragma unroll
        for (int j = 0; j < 8; ++j) ((f32x4*)dst)[lane + 64 * j] = v[j] * rs * ((const f32x4*)fn)[lane + 64 * j];
    }
}

typedef const __attribute__((address_space(4))) Params* KParams;
__global__ void __launch_bounds__(512, 2) mega_fwd(Params p_arg) {
    extern __shared__ __attribute__((aligned(16))) unsigned char smem[];
    cg::grid_group grid = cg::this_grid();
    const int ph_lo = p_arg.ph_lo, ph_hi = p_arg.ph_hi;
    volatile LAS unsigned* xst = (volatile LAS unsigned*)((PG8_LAS unsigned char*)smem + 131072);
    if (threadIdx.x == 0) { xst[0] = 0u; xst[1] = 0u; }
    __syncthreads();
    const XcdBarrier xb = xcd_barrier_post((unsigned*)(p_arg.ws + WS_BAR), xst);
#ifndef REP_MASK
#define REP_MASK 0x000
#endif
#ifndef PHMASK
#define PHMASK 0xfff
#endif
#define PHASE(n, ...) if constexpr ((PHMASK >> (n)) & 1) if (ph_lo <= (n) && (n) < ph_hi) { if ((n) > ph_lo) xcd_barrier(xb); \
        KParams kp = (KParams)__builtin_amdgcn_kernarg_segment_ptr(); asm volatile("" : "+s"(kp) :: "memory"); const Params& p = *(const Params*)kp; \
        PG8_LAS unsigned char* lds = (PG8_LAS unsigned char*)smem; unsigned char* ws = p.ws; (void)lds; (void)ws; \
        bf16_t* Abuf = (bf16_t*)(ws + WS_A); bf16_t* UH = (bf16_t*)(ws + WS_UH); bf16_t* Og = (bf16_t*)(ws + WS_OG); bf16_t* Ob = (bf16_t*)(ws + WS_O); \
        float* part = (float*)(ws + WS_PART); float* hx = (float*)(ws + WS_HX); float* partx = (float*)(ws + WS_PARTX); float* hmain = p.out + O_YP; (void)partx; (void)Abuf; (void)UH; (void)Og; (void)Ob; (void)part; (void)hx; (void)hmain; \
        { __VA_ARGS__ } if constexpr ((REP_MASK >> (n)) & 1) { asm volatile("" ::: "memory"); __VA_ARGS__ } }
    PHASE(0, phase_pre(p, smem);)
    PHASE(1, Epi<0> E{}; E.outb = UH; E.part_in = part; run_gemm<0>(lds, Abuf, (const bf16_t*)(ws + WS_BT1IN), RT, 11264, 2048, E);
             convert_in_tail(p, smem, 33 * 44, IT_PRE_END, IT_1OUT_END); convert_in_tail(p, smem, 33 * 44, IT_MIX_END, IT_2IN_SPLIT);)
#ifdef EXP_G2
    PHASE(2, Epi<1> E{}; E.outb = Abuf; E.hmain = hmain; E.hx = hx; E.part_out = part + RT; E.gvec = nullptr; E.scale = 0.25f; run_gemm<1>(lds, UH, (const bf16_t*)(ws + WS_BT1OUT), NPR, 2048, 5632, E);
             E.gvec = p.in[11]; run_gemm<1>(lds, UH, (const bf16_t*)(ws + WS_BT1OUT), NPR, 2048, 5632, E);
             skinny_phase<1>(smem, UH + (size_t)NPR * FF, FF, (const bf16_t*)(ws + WS_BT1OUT), 5632, nullptr, nullptr, Abuf, hx, part + RT, p.in[11], 0.5f, nullptr, nullptr);)
#else
    PHASE(2, Epi<1> E{}; E.outb = Abuf; E.hmain = hmain; E.hsrc = p.in[0]; E.hx = hx; E.part_out = part + RT; E.gvec = p.in[11]; E.scale = 0.5f; run_gemm<1>(lds, UH, (const bf16_t*)(ws + WS_BT1OUT), NPR, 2048, 5632, E);
             skinny_phase<1>(smem, UH + (size_t)NPR * FF, FF, (const bf16_t*)(ws + WS_BT1OUT), 5632, nullptr, nullptr, Abuf, hx, part + RT, p.in[11], 0.5f, nullptr, nullptr);)
#endif
    PHASE(3, Epi<2> E{}; E.outb = UH; E.part_in = part + RT; run_gemm<2>(lds, Abuf, (const bf16_t*)(ws + WS_BTIN), RT, NIN_PAD, 2048, E);
             convert_in_tail(p, smem, 33 * 35, IT_1OUT_END, IT_MIX_END); convert_in_tail(p, smem, 33 * 35, IT_2IN_SPLIT, IT_2IN_END);)
    PHASE(4, phase_mixer_a(p, smem);)
    PHASE(5, phase_mixer_b(p, smem);)
    PHASE(6, phase_gnorm(p);)
    PHASE(7, Epi<3> E3{}; E3.outb = Abuf; E3.U = UH; E3.gbias = p.in[19]; E3.uoff = U_GA; E3.boff = 0; run_gemm<3>(lds, Og, (const bf16_t*)(ws + WS_BTGO), NPR, 2048, 1024, E3);
             Epi<4> E4{}; E4.outb = Abuf; E4.U = UH; E4.gbias = p.in[19]; E4.uoff = U_GB; E4.boff = DM; run_gemm<4>(lds, Ob, (const bf16_t*)(ws + WS_BTSO), NPR, 2048, 1024, E4);
             skinny_phase<34>(smem, Og + (size_t)NPR * 1024, 1024, (const bf16_t*)(ws + WS_BTGO), 1024, Ob + (size_t)NPR * 1024, (const bf16_t*)(ws + WS_BTSO), Abuf, nullptr, nullptr, nullptr, 0.f, UH, p.in[19]);)
    PHASE(8, Epi<1> E{}; E.outb = Og; E.hmain = hmain; E.hsrc = hmain; E.hx = hx; E.part_out = part + 2 * RT; E.gvec = p.in[21]; E.scale = 1.0f; run_gemm<1>(lds, Abuf, (const bf16_t*)(ws + WS_BTOUT), NPR, 2048, 2048, E);
             skinny_phase<1>(smem, Abuf + (size_t)NPR * DM, DM, (const bf16_t*)(ws + WS_BTOUT), 2048, nullptr, nullptr, Og, hx, part + 2 * RT, p.in[21], 1.0f, nullptr, nullptr);)
    PHASE(9, Epi<0> E{}; E.outb = UH; E.part_in = part + 2 * RT; run_gemm<0>(lds, Og, (const bf16_t*)(ws + WS_BT2IN), RT, 11264, 2048, E);
             convert_in_tail(p, smem, 33 * 44, IT_2IN_END, IT_END);)
    const bool fused_final = (gridDim.x == 256);
    PHASE(10, if (fused_final) {
                 Epi<5> E{}; E.hmain = hmain; E.hsrc = hmain; E.part_out = part + 3 * RT; E.scale = 0.5f; E.cnt = (unsigned*)(ws + WS_CNT); E.fnorm = p.in[24];
                 run_gemm<5>(lds, UH, (const bf16_t*)(ws + WS_BT2OUT), NPR, 2048, 5632, E);
                 skinny_phase<15>(smem, UH + (size_t)NPR * FF, FF, (const bf16_t*)(ws + WS_BT2OUT), 5632, nullptr, nullptr, nullptr, hx, part + 3 * RT, nullptr, 0.5f, nullptr, nullptr, (unsigned*)(ws + WS_CNT) + 64 * 36, p.in[24], p.out + O_YS);
             } else {
                 Epi<1> E{}; E.outb = nullptr; E.hmain = hmain; E.hsrc = hmain; E.hx = hx; E.part_out = nullptr; E.gvec = nullptr; E.scale = 0.5f; run_gemm<1>(lds, UH, (const bf16_t*)(ws + WS_BT2OUT), NPR, 2048, 5632, E);
                 skinny_phase<1>(smem, UH + (size_t)NPR * FF, FF, (const bf16_t*)(ws + WS_BT2OUT), 5632, nullptr, nullptr, nullptr, hx, partx, nullptr, 0.5f, nullptr, nullptr);
             })
    if (!fused_final) { PHASE(11, phase_final(p);) }
#undef PHASE
}

extern "C" void kernel_launch(void* const* d_in, const int* in_sizes, int n_in, void* d_out, int out_size, void* d_ws, size_t ws_size, hipStream_t stream) {
    static int grid = 0;
    if (grid == 0) {
        if (n_in != 25 || out_size != 23953408 || ws_size < WS_END) { fprintf(stderr, "kernel_launch: unexpected shapes n_in %d out %d ws %zu (need %zu)\n", n_in, out_size, ws_size, (size_t)WS_END); grid = -1; return; }
        int dev = 0, cus = 0, per_cu = 0;
        hipGetDevice(&dev); hipDeviceGetAttribute(&cus, hipDeviceAttributeMultiprocessorCount, dev);
        if (hipFuncSetAttribute((const void*)mega_fwd, hipFuncAttributeMaxDynamicSharedMemorySize, LDS_BYTES) != hipSuccess) { fprintf(stderr, "kernel_launch: hipFuncSetAttribute failed\n"); grid = -1; return; }
        hipOccupancyMaxActiveBlocksPerMultiprocessor(&per_cu, (const void*)mega_fwd, 512, LDS_BYTES);
        if (per_cu < 1) { fprintf(stderr, "kernel_launch: occupancy query says %d blocks per CU\n", per_cu); per_cu = 1; }
        (void)hipGetLastError();
        grid = cus;
        if (grid > 256) grid = 256;
    }
    if (grid < 0) return;
    if (hipMemsetAsync((char*)d_ws + WS_BAR, 0, (size_t)(XCD_BAR_WORDS + CNT_WORDS) * 4, stream) != hipSuccess) { fprintf(stderr, "kernel_launch: memset of the barrier words failed\n"); return; }
    Params p{};
    for (int i = 0; i < 25; ++i) p.in[i] = (const float*)d_in[i];
    p.out = (float*)d_out; p.ws = (unsigned char*)d_ws;
#if MK_LAUNCHES == 1
    p.ph_lo = 0; p.ph_hi = NPHASE;
    void* args[] = {&p};
    hipError_t e = hipLaunchCooperativeKernel((const void*)mega_fwd, dim3(grid), dim3(512), args, LDS_BYTES, stream);
    if (e != hipSuccess) fprintf(stderr, "cooperative launch failed: %s (grid %d)\n", hipGetErrorString(e), grid);
#else
    for (int ph = 0; ph < NPHASE; ++ph) { p.ph_lo = ph; p.ph_hi = ph + 1; hipLaunchKernelGGL(mega_fwd, dim3(grid), dim3(512), LDS_BYTES, stream, p); }
#endif
}
```
